# Optimizing an MI355X kernel written in HIP

```python
import math
import jax, jax.numpy as jnp
from jax import lax
import numpy as np

D_MODEL = 1024
BATCH = 16
SEQ = 2048
DEPTH = 2

CHUNK = 64
Q_BLOCK = 128
D_MIX = D_MODEL
RMS_EPS = 1e-6
MLA_NOPE = 64
MLA_ROPE = 32
MLA_V = 64
MLA_HEADS = D_MIX // (2 * MLA_V)
MLA_Q_RANK = D_MODEL // 4
MLA_KV_RANK = D_MODEL // 8
ROPE_THETA = 10000.0
SB_DIM = 64
SB_HEADS = D_MIX // (4 * SB_DIM)
SB_WIDTH = SB_HEADS * SB_DIM
CA_DIM = 64
CA_HEADS = D_MIX // (4 * CA_DIM)
CA_WIDTH = CA_HEADS * CA_DIM
CA_LEFT_CHUNKS = 8
REL_CLIP = 256
D_IN = MLA_Q_RANK + MLA_KV_RANK + MLA_ROPE + 3 * SB_WIDTH + 3 * CA_WIDTH
N_EXPERTS = 32
TOP_K = 4
D_FF = D_MODEL
SWIGLU_LIMIT = 7.0
SWIGLU_ALPHA = 1.702
EXPERT_BLOCK = 128

kernel_name = "hybrid_mla_stickbreak_chunkbias_moe"


def _rmsnorm(x, g):
    xf = x.astype(jnp.float32)
    y = xf * lax.rsqrt(jnp.mean(xf * xf, axis=-1, keepdims=True) + RMS_EPS)
    return (y * g.astype(jnp.float32)).astype(x.dtype)


def _rope(x, pos):
    d = x.shape[-1]
    inv = ROPE_THETA ** (-jnp.arange(0, d, 2, dtype=jnp.float32) / d)
    ang = pos.astype(jnp.float32)[..., None] * inv
    cos = jnp.cos(ang)[:, :, None, :]
    sin = jnp.sin(ang)[:, :, None, :]
    xf = x.astype(jnp.float32)
    x1, x2 = jnp.split(xf, 2, axis=-1)
    return jnp.concatenate([x1 * cos - x2 * sin, x2 * cos + x1 * sin], axis=-1).astype(x.dtype)


def _to_qblocks(a):
    b, s = a.shape[:2]
    return jnp.moveaxis(a.reshape((b, s // Q_BLOCK, Q_BLOCK) + a.shape[2:]), 1, 0)


def _from_qblocks(o):
    nb, b, qb = o.shape[:3]
    return jnp.moveaxis(o, 0, 1).reshape((b, nb * qb) + o.shape[3:])


def _split_points():
    sizes = [MLA_Q_RANK, MLA_KV_RANK, MLA_ROPE, SB_WIDTH, SB_WIDTH, SB_WIDTH, CA_WIDTH, CA_WIDTH, CA_WIDTH]
    pts, acc = [], 0
    for s in sizes[:-1]:
        acc += s
        pts.append(acc)
    return pts


def _mla(cq, ckv, kpe, pos, q_norm, w_uq, kv_norm, w_ukv):
    b, s, _ = cq.shape
    q = (_rmsnorm(cq, q_norm) @ w_uq).reshape(b, s, MLA_HEADS, MLA_NOPE + MLA_ROPE)
    q_nope, q_pe = q[..., :MLA_NOPE], _rope(q[..., MLA_NOPE:], pos)
    kv = (_rmsnorm(ckv, kv_norm) @ w_ukv).reshape(b, s, MLA_HEADS, MLA_NOPE + MLA_V)
    k_nope, v = kv[..., :MLA_NOPE], kv[..., MLA_NOPE:]
    k_pe = _rope(kpe[:, :, None, :], pos)[:, :, 0]
    scale = 1.0 / math.sqrt(MLA_NOPE + MLA_ROPE)
    key_chunk = jnp.arange(s) // CHUNK

    def block(args):
        blk, qn, qp = args
        sc = (jnp.einsum('bqhd,bkhd->bhqk', qn, k_nope)
              + jnp.einsum('bqhd,bkd->bhqk', qp, k_pe)).astype(jnp.float32) * scale
        q_chunk = (blk * Q_BLOCK + jnp.arange(Q_BLOCK)) // CHUNK
        allowed = key_chunk[None, :] <= q_chunk[:, None]
        p = jax.nn.softmax(jnp.where(allowed, sc, -jnp.inf), axis=-1)
        return jnp.einsum('bhqk,bkhd->bqhd', p.astype(v.dtype), v)

    nb = s // Q_BLOCK
    o = lax.map(block, (jnp.arange(nb), _to_qblocks(q_nope), _to_qblocks(q_pe)))
    return _from_qblocks(o).reshape(b, s, MLA_HEADS * MLA_V)


def _stick_breaking(q, k, v):
    b, s, _ = q.shape
    q = q.reshape(b, s, SB_HEADS, SB_DIM)
    k = k.reshape(b, s, SB_HEADS, SB_DIM)
    v = v.reshape(b, s, SB_HEADS, SB_DIM)
    scale = 1.0 / math.sqrt(SB_DIM)
    key_idx = jnp.arange(s)

    def block(args):
        blk, qb = args
        z = jnp.einsum('bqhd,bkhd->bhqk', qb, k).astype(jnp.float32) * scale
        t = blk * Q_BLOCK + jnp.arange(Q_BLOCK)
        strict = key_idx[None, :] < t[:, None]
        log_keep = jnp.where(strict, jax.nn.log_sigmoid(-z), 0.0)
        between = lax.cumsum(log_keep, axis=3, reverse=True) - log_keep
        a = jnp.where(strict, jnp.exp(jax.nn.log_sigmoid(z) + between), 0.0)
        return jnp.einsum('bhqk,bkhd->bqhd', a.astype(v.dtype), v)

    nb = s // Q_BLOCK
    o = lax.map(block, (jnp.arange(nb), _to_qblocks(q)))
    return _from_qblocks(o).reshape(b, s, SB_WIDTH)


def _chunk_band_attention(q, k, v, rel_bias):
    b, s, _ = q.shape
    nc = s // CHUNK
    w = CA_LEFT_CHUNKS + 1
    qc = q.reshape(b, nc, CHUNK, CA_HEADS, CA_DIM)
    pad = ((0, 0), (CA_LEFT_CHUNKS, 0), (0, 0), (0, 0), (0, 0))
    kc = jnp.pad(k.reshape(b, nc, CHUNK, CA_HEADS, CA_DIM), pad)
    vc = jnp.pad(v.reshape(b, nc, CHUNK, CA_HEADS, CA_DIM), pad)
    idx = jnp.arange(nc)[:, None] + jnp.arange(w)[None, :]
    kb = kc[:, idx].reshape(b, nc, w * CHUNK, CA_HEADS, CA_DIM)
    vb = vc[:, idx].reshape(b, nc, w * CHUNK, CA_HEADS, CA_DIM)
    valid = jnp.repeat(idx >= CA_LEFT_CHUNKS, CHUNK, axis=1)
    rel = (CA_LEFT_CHUNKS * CHUNK + jnp.arange(CHUNK))[:, None] - jnp.arange(w * CHUNK)[None, :]
    bias = rel_bias[:, jnp.clip(rel, -REL_CLIP, REL_CLIP) + REL_CLIP]
    sc = jnp.einsum('bcqhd,bckhd->bhcqk', qc, kb).astype(jnp.float32) / math.sqrt(CA_DIM)
    sc = sc + bias[:, None].astype(jnp.float32)
    sc = jnp.where(valid[None, None, :, None, :], sc, -jnp.inf)
    p = jax.nn.softmax(sc, axis=-1)
    o = jnp.einsum('bhcqk,bckhd->bcqhd', p.astype(vb.dtype), vb)
    return o.reshape(b, s, CA_WIDTH)


def _moe(h, w_router, b_router, w_gu, b_gu, w_dn, b_dn):
    bsz, seq, d = h.shape
    n_tok = bsz * seq
    xt = h.reshape(n_tok, d)
    logits = (xt @ w_router + b_router).astype(jnp.float32)
    top_val, top_idx = lax.top_k(logits, TOP_K)
    gate = jax.nn.softmax(top_val, axis=-1)
    n_assign = n_tok * TOP_K
    e_flat = top_idx.reshape(n_assign)
    tok_flat = jnp.arange(n_assign, dtype=jnp.int32) // TOP_K
    g_flat = gate.reshape(n_assign)
    order = jnp.argsort(e_flat)
    e_sorted = e_flat[order]
    sizes = jnp.bincount(e_flat, length=N_EXPERTS)
    padded = (sizes + EXPERT_BLOCK - 1) // EXPERT_BLOCK * EXPERT_BLOCK
    starts = jnp.cumsum(sizes) - sizes
    p_ends = jnp.cumsum(padded)
    p_starts = p_ends - padded
    dest = p_starts[e_sorted] + jnp.arange(n_assign) - starts[e_sorted]
    n_rows = -(-(n_assign + N_EXPERTS * (EXPERT_BLOCK - 1)) // EXPERT_BLOCK) * EXPERT_BLOCK
    n_blk = n_rows // EXPERT_BLOCK
    row_tok = jnp.full((n_rows,), n_tok, jnp.int32).at[dest].set(tok_flat[order])
    row_gate = jnp.zeros((n_rows,), jnp.float32).at[dest].set(g_flat[order])
    blk_exp = jnp.minimum(jnp.searchsorted(p_ends, jnp.arange(n_blk) * EXPERT_BLOCK, side='right'),
                          N_EXPERTS - 1)
    x_pad = jnp.concatenate([xt, jnp.zeros((1, d), xt.dtype)], axis=0)
    xs = x_pad[row_tok].reshape(n_blk, EXPERT_BLOCK, d)

    def expert_rows(args):
        xb, e = args
        gu = xb @ w_gu[e] + b_gu[e]
        g, u = jnp.split(gu, 2, axis=-1)
        g = jnp.minimum(g, SWIGLU_LIMIT)
        u = jnp.clip(u, -SWIGLU_LIMIT, SWIGLU_LIMIT)
        act = (u + 1.0) * (g * jax.nn.sigmoid(SWIGLU_ALPHA * g))
        return act @ w_dn[e] + b_dn[e]

    ys = lax.map(expert_rows, (xs, blk_exp)).reshape(n_rows, d)
    ys = ys * row_gate[:, None].astype(ys.dtype)
    out = jnp.zeros((n_tok + 1, d), ys.dtype).at[row_tok].add(ys)
    return out[:n_tok].reshape(bsz, seq, d)


def setup_inputs(seed: int = 0) -> dict:
    key = jax.random.key(seed)
    ks = jax.random.split(key, 24)
    f32 = jnp.float32

    def nrm(k, shape, scale):
        return jax.random.normal(k, shape, f32) * scale

    def gain(k, shape):
        return 1.0 + 0.05 * jax.random.normal(k, shape, f32)

    L = DEPTH
    x = nrm(ks[0], (BATCH, SEQ, D_MODEL), 1.0)
    offs = jax.random.randint(ks[1], (BATCH, 1), 0, 256, dtype=jnp.int32) * CHUNK
    positions = offs + jnp.arange(SEQ, dtype=jnp.int32)[None, :]
    return {
        "x": x,
        "positions": positions,
        "attn_norm": gain(ks[2], (L, D_MODEL)),
        "w_in": nrm(ks[3], (L, D_MODEL, D_IN), D_MODEL ** -0.5),
        "q_norm": gain(ks[4], (L, MLA_Q_RANK)),
        "w_uq": nrm(ks[5], (L, MLA_Q_RANK, MLA_HEADS * (MLA_NOPE + MLA_ROPE)), MLA_Q_RANK ** -0.5),
        "kv_norm": gain(ks[6], (L, MLA_KV_RANK)),
        "w_ukv": nrm(ks[7], (L, MLA_KV_RANK, MLA_HEADS * (MLA_NOPE + MLA_V)), MLA_KV_RANK ** -0.5),
        "rel_bias": nrm(ks[8], (L, CA_HEADS, 2 * REL_CLIP + 1), 0.2),
        "mix_norm": gain(ks[9], (L, D_MIX)),
        "w_o": nrm(ks[10], (L, D_MIX, D_MODEL), D_MIX ** -0.5),
        "ffn_norm": gain(ks[11], (L, D_MODEL)),
        "w_router": nrm(ks[12], (L, D_MODEL, N_EXPERTS), D_MODEL ** -0.5),
        "b_router": nrm(ks[13], (L, N_EXPERTS), 0.01),
        "w_gate_up": nrm(ks[14], (L, N_EXPERTS, D_MODEL, 2 * D_FF), D_MODEL ** -0.5),
        "b_gate_up": nrm(ks[15], (L, N_EXPERTS, 2 * D_FF), 0.02),
        "w_down": nrm(ks[16], (L, N_EXPERTS, D_FF, D_MODEL), D_FF ** -0.5),
        "b_down": nrm(ks[17], (L, N_EXPERTS, D_MODEL), 0.02),
        "final_norm": gain(ks[18], (D_MODEL,)),
    }


def reference(x, positions, attn_norm, w_in, q_norm, w_uq, kv_norm, w_ukv, rel_bias, mix_norm,
              w_o, ffn_norm, w_router, b_router, w_gate_up, b_gate_up, w_down, b_down, final_norm):
    a_w = MLA_HEADS * MLA_V
    for l in range(DEPTH):
        h = _rmsnorm(x, attn_norm[l])
        proj = h @ w_in[l]
        cq, ckv, kpe, sb_q, sb_k, sb_v, ca_q, ca_k, ca_v = jnp.split(proj, _split_points(), axis=-1)
        o_a = _mla(cq, ckv, kpe, positions, q_norm[l], w_uq[l], kv_norm[l], w_ukv[l])
        o_b = _stick_breaking(sb_q, sb_k, sb_v)
        o_c = _chunk_band_attention(ca_q, ca_k, ca_v, rel_bias[l])
        g = mix_norm[l]
        mixed = jnp.concatenate([
            _rmsnorm(o_a, g[:a_w]),
            _rmsnorm(o_b, g[a_w:a_w + SB_WIDTH]),
            _rmsnorm(o_c, g[a_w + SB_WIDTH:]),
        ], axis=-1)
        x = x + mixed @ w_o[l]
        h = _rmsnorm(x, ffn_norm[l])
        x = x + _moe(h, w_router[l], b_router[l], w_gate_up[l], b_gate_up[l], w_down[l], b_down[l])
    return _rmsnorm(x, final_norm)
```

```cpp
#include <hip/hip_runtime.h>
#include <cstdio>
#include <cstdint>

#ifndef GU_FP8
#define GU_FP8 1
#endif
#ifndef BG_CONV
#define BG_CONV 1
#endif
#ifndef DMA_IN_MMA
#define DMA_IN_MMA 0
#endif
#ifndef PREP_FUSED
#define PREP_FUSED 1
#endif
#ifndef YS_FP8
#define YS_FP8 1
#endif
#ifndef MIX_FUSED
#define MIX_FUSED 1
#endif
#ifndef DG_FP8
#define DG_FP8 0
#endif
#ifndef DN_FP8
#define DN_FP8 1
#endif
#ifndef NORM_FOLD
#define NORM_FOLD 1
#endif
#ifndef GEMM_PRIO
#define GEMM_PRIO 0
#endif
#ifndef MK_PER_PHASE
#define MK_PER_PHASE 0
#endif

#define GAS __attribute__((address_space(1)))
#define LAS __attribute__((address_space(3)))
typedef unsigned short bf16;
typedef short bf16x8 __attribute__((ext_vector_type(8)));
typedef short s16x4 __attribute__((ext_vector_type(4)));
typedef float f32x2 __attribute__((ext_vector_type(2)));
typedef float f32x4 __attribute__((ext_vector_type(4)));
typedef float f32x16 __attribute__((ext_vector_type(16)));
typedef unsigned u32x2 __attribute__((ext_vector_type(2)));
typedef unsigned u32x4 __attribute__((ext_vector_type(4)));
typedef __bf16 bf16x2_t __attribute__((ext_vector_type(2)));
typedef short v4i16_t __attribute__((ext_vector_type(4)));

constexpr int NTOK = 32768, SEQ = 2048, DM = 1024, DEPTH = 2;
constexpr int D_IN = 1952, NPROJ = 2048;
constexpr int NEXP = 32, TOPK = 4;
constexpr int NWAVES = 8;
constexpr float RMS_EPS = 1e-6f;
constexpr float LOG2E = 1.4426950408889634f;
constexpr int PC_CQ = 0, PC_CKV = 256, PC_KPE = 384, PC_SBQ = 512, PC_SBK = 768, PC_SBV = 1024, PC_CAQ = 1280, PC_CAK = 1536, PC_CAV = 1792;

constexpr size_t MiB = 1u << 20;
constexpr size_t WS_CTL = 0, CTL_ZERO_BYTES = 1 * MiB;
constexpr size_t WS_WIN = 2 * MiB;
constexpr size_t WS_WUQ = WS_WIN + 8 * MiB;
constexpr size_t WS_WUKV = WS_WUQ + 1 * MiB;
constexpr size_t WS_WO = WS_WUKV + 1 * MiB;
constexpr size_t WS_ROPE = WS_WO + 4 * MiB;
constexpr size_t WS_RSTD = WS_ROPE + 4 * MiB;
constexpr size_t WS_KPE = WS_RSTD + 1 * MiB;
constexpr size_t WS_TOK = WS_KPE + 2 * MiB;
constexpr size_t WS_GATE = WS_TOK + 4 * MiB;
constexpr size_t WS_WGU = 32 * MiB;
constexpr size_t WS_WDN = WS_WGU + 256 * MiB;
constexpr size_t WS_H = WS_WDN + 128 * MiB;
constexpr size_t WS_PROJ = WS_H + 64 * MiB;
constexpr size_t WS_QB = WS_PROJ + 128 * MiB;
constexpr size_t WS_KVB = WS_QB + 48 * MiB;
constexpr size_t WS_MIXED = WS_KVB + 64 * MiB;
constexpr size_t WS_ACT = WS_MIXED + 64 * MiB;
constexpr size_t WS_YS = WS_ACT + 272 * MiB;
constexpr size_t WS_H8 = WS_YS + 256 * MiB;
constexpr size_t WS_R16 = WS_H8 + 32 * MiB;
constexpr size_t WS_MSTAT = WS_R16 + 64 * MiB;
constexpr size_t WS_END = WS_MSTAT + 4 * MiB;
constexpr float W_SCALE = 64.f, H_SCALE = 8.f, ACT_SCALE = 4.f, YS_SCALE = 32.f;
constexpr size_t WS_WRT = WS_GATE + 4 * MiB;
constexpr size_t WS_RSIN = WS_WRT + 512 * 1024;
static_assert(WS_WRT + 1 * MiB <= WS_WGU, "ws map");
constexpr int CW_BAR = 4096;
constexpr int CW_CNT = 16384;

constexpr int LDS_BYTES = 163840;
constexpr int LDS_MISC = 147456;
constexpr int LDS_CTL = 163584;
constexpr int GEMM_SLOT0 = 131072, GEMM_SLOT_BYTES = 3072;

#define LDS_WAIT() asm volatile("s_waitcnt lgkmcnt(0)" ::: "memory")
#define VM_WAIT() asm volatile("s_waitcnt vmcnt(0)" ::: "memory")
__device__ __forceinline__ unsigned cvtpk(float lo, float hi) { f32x2 v = {lo, hi}; bf16x2_t b = __builtin_convertvector(v, bf16x2_t); return __builtin_bit_cast(unsigned, b); }
__device__ __forceinline__ unsigned pk4_fp8(float a, float b, float c, float d) { int v = 0; v = __builtin_amdgcn_cvt_pk_fp8_f32(a, b, v, false); v = __builtin_amdgcn_cvt_pk_fp8_f32(c, d, v, true); return (unsigned)v; }
__device__ __forceinline__ unsigned pk4_fp8_sat(float a, float b, float c, float d) { return pk4_fp8(a, b, c, d); }
typedef short s16x2_t __attribute__((ext_vector_type(2)));
__device__ __forceinline__ unsigned pk4_fp8_scaled(float a, float b, float c, float d, float inv_scale) {
    s16x2_t r = __builtin_amdgcn_cvt_scalef32_pk_fp8_f32((s16x2_t){0, 0}, a, b, inv_scale, false);
    r = __builtin_amdgcn_cvt_scalef32_pk_fp8_f32(r, c, d, inv_scale, true);
    return __builtin_bit_cast(unsigned, r); }
__device__ __forceinline__ float bf_lo(unsigned u) { return __builtin_bit_cast(float, u << 16); }
__device__ __forceinline__ float bf_hi(unsigned u) { return __builtin_bit_cast(float, u & 0xffff0000u); }
#define SWZ_I(x, k) __builtin_amdgcn_ds_swizzle((x), ((k) << 10) | 0x1F)
#define SWZ_F(x, k) __builtin_bit_cast(float, __builtin_amdgcn_ds_swizzle(__builtin_bit_cast(int, (x)), ((k) << 10) | 0x1F))
__device__ __forceinline__ float x32_sum(float a, float b) {
    auto rr = __builtin_amdgcn_permlane32_swap(__builtin_bit_cast(unsigned, a), __builtin_bit_cast(unsigned, b), false, false);
    return __builtin_bit_cast(float, rr[0]) + __builtin_bit_cast(float, rr[1]); }
__device__ __forceinline__ float x32_max(float a) {
    auto rr = __builtin_amdgcn_permlane32_swap(__builtin_bit_cast(unsigned, a), __builtin_bit_cast(unsigned, a), false, false);
    return fmaxf(__builtin_bit_cast(float, rr[0]), __builtin_bit_cast(float, rr[1])); }
__device__ __forceinline__ int x32_maxi(int a) {
    auto rr = __builtin_amdgcn_permlane32_swap((unsigned)a, (unsigned)a, false, false);
    const int u = (int)rr[0], v = (int)rr[1]; return u > v ? u : v; }
__device__ __forceinline__ float shx(float v, int lane, int k) { return __builtin_bit_cast(float, __builtin_amdgcn_ds_bpermute((lane ^ k) << 2, __builtin_bit_cast(int, v))); }
__device__ __forceinline__ int shxi(int v, int lane, int k) { return __builtin_amdgcn_ds_bpermute((lane ^ k) << 2, v); }
__device__ __forceinline__ float wave_sum(float v, int lane) {
    v += shx(v, lane, 1); v += shx(v, lane, 2); v += shx(v, lane, 4); v += shx(v, lane, 8); v += shx(v, lane, 16); v += shx(v, lane, 32);
    return v;
}
__device__ __forceinline__ float ex2(float x) { return __builtin_amdgcn_exp2f(x); }
__device__ __forceinline__ float lg2(float x) { return __builtin_amdgcn_logf(x); }
#define MFMA32(a, b, c) __builtin_amdgcn_mfma_f32_32x32x16_bf16((a), (b), (c), 0, 0, 0)
#define MFMA16(a, b, c) __builtin_amdgcn_mfma_f32_16x16x32_bf16((a), (b), (c), 0, 0, 0)

#define XB_TMO      128
#define XB_XCNT(j)  (256  + 64 * (j))
#define XB_XSUB(j)  (1280 + 64 * (j))
#define XB_XGEN(j)  (2304 + 64 * (j))
#define XB_TOP      3328
#define XB_TOPGEN   3392
#define XCD_BAR_WORDS 3456
#define XB_SPIN_CAP (1u << 18)
__device__ __forceinline__ unsigned xb_ld(unsigned* p)              { return __hip_atomic_load(p, __ATOMIC_RELAXED, __HIP_MEMORY_SCOPE_AGENT); }
__device__ __forceinline__ unsigned xb_add(unsigned* p, unsigned v) { return __hip_atomic_fetch_add(p, v, __ATOMIC_RELAXED, __HIP_MEMORY_SCOPE_AGENT); }
__device__ __forceinline__ unsigned xb_xcc_id() { return (unsigned)__builtin_amdgcn_s_getreg((3 << 11) | 20) & 0xFu; }
#define XB_SPIN(cond, bar) do { unsigned _sp = 0; while (cond) { __builtin_amdgcn_s_sleep(1); \
    if ((++_sp & 255u) == 0u) { if (xb_ld(&(bar)[XB_TMO])) break; if (_sp > XB_SPIN_CAP) { atomicAdd(&(bar)[XB_TMO], 1u); break; } } } } while (0)
struct XcdBarrier { unsigned* bar; unsigned x; volatile LAS unsigned* st; int w; };
__device__ __forceinline__ int lane_id() { int r; asm volatile("v_mbcnt_lo_u32_b32 %0, -1, 0\n\tv_mbcnt_hi_u32_b32 %0, -1, %0" : "=v"(r)); return r; }
__device__ __forceinline__ XcdBarrier xcd_barrier_post(unsigned* bar, volatile LAS unsigned* st, int w) {
    XcdBarrier b; b.bar = bar; b.x = xb_xcc_id(); b.st = st; b.w = w;
    if (w == 0 && lane_id() == 0) (void)xb_add(&bar[XB_XCNT(b.x)], 1u);
    return b;
}
__device__ __forceinline__ void xcd_barrier_complete(unsigned* bar, unsigned x, unsigned& nloc, unsigned& nx) {
    const unsigned G = gridDim.x * gridDim.y * gridDim.z;
    unsigned sum, cnt, mine, sp = 0u;
    for (;;) {
        sum = 0u; cnt = 0u; mine = 0u;
#pragma unroll
        for (unsigned j = 0; j < 16; ++j) { const unsigned c = xb_ld(&bar[XB_XCNT(j)]); sum += c; cnt += (c > 0u) ? 1u : 0u; mine = (j == x) ? c : mine; }
        if (sum == G) break;
        __builtin_amdgcn_s_sleep(1);
        if ((++sp & 255u) == 0u) { if (xb_ld(&bar[XB_TMO])) break; if (sp > XB_SPIN_CAP) { atomicAdd(&bar[XB_TMO], 1u); break; } }
    }
    nloc = mine > 0u ? mine : 1u; nx = cnt > 0u ? cnt : 1u;
}
__device__ __forceinline__ void xcd_barrier(const XcdBarrier& b) {
    asm volatile("s_waitcnt vmcnt(0)" ::: "memory");
    __syncthreads();
    if (b.w == 0 && lane_id() == 0) {
        unsigned* bar = b.bar; unsigned bx_ = b.x; asm volatile("" : "+s"(bar), "+s"(bx_));
        __builtin_amdgcn_s_waitcnt(0);
        unsigned nloc = b.st[0], nx = b.st[1];
        if (nloc == 0u) { xcd_barrier_complete(bar, bx_, nloc, nx); b.st[0] = nloc; b.st[1] = nx; }
        const unsigned old = xb_add(&bar[XB_XSUB(bx_)], 1u);
        const unsigned gen = old / nloc;
        if (old + 1u == (gen + 1u) * nloc) {
            __builtin_amdgcn_fence(__ATOMIC_RELEASE, "agent");
            asm volatile("s_waitcnt vmcnt(0)" ::: "memory");
            const unsigned og = xb_add(&bar[XB_TOP], 1u);
            const unsigned tg = og / nx;
            if (og + 1u == (tg + 1u) * nx) xb_add(&bar[XB_TOPGEN], 1u);
            else XB_SPIN(xb_ld(&bar[XB_TOPGEN]) == tg, bar);
            __builtin_amdgcn_fence(__ATOMIC_ACQUIRE, "agent");
            xb_add(&bar[XB_XGEN(bx_)], 1u);
            asm volatile("s_waitcnt vmcnt(0)" ::: "memory");
        } else {
            XB_SPIN(xb_ld(&bar[XB_XGEN(bx_)]) == gen, bar);
            __builtin_amdgcn_fence(__ATOMIC_ACQUIRE, "agent");
            asm volatile("s_waitcnt vmcnt(0)" ::: "memory");
        }
    }
    __syncthreads();
}

namespace pg8 {
constexpr int BM = 256, BK = 64, HALF = 128, HTB = HALF * BK * 2, STAGE_BYTES = 8 * HTB, NXCD = 8, WGM = 8;
__host__ __device__ __forceinline__ int lds_byte(int r, int c) { const int st = (r >> 4) * 2 + (c >> 5), rr = r & 15, cc = c & 31, ob = rr * 64 + cc * 2; return st * 1024 + (ob ^ (((ob >> 9) & 1) << 5)); }
__host__ __device__ __forceinline__ void stage_rc(int b, int& R, int& C) { const int st = b / 1024, sb = b % 1024, swz = sb ^ (((sb >> 9) & 1) << 5); R = (st >> 1) * 16 + swz / 64; C = (st & 1) * 32 + (swz % 64) / 2; }
__host__ __device__ __forceinline__ int perm32(int rho) { const int n = rho >> 4, i = rho & 15; return 8 * (i >> 2) + 4 * n + (i & 3); }
struct Unit { int pm, pn, e, nvalid, mt; };

typedef int v4i_t __attribute__((ext_vector_type(4)));
typedef int v8i_t __attribute__((ext_vector_type(8)));
template <class Epi, class Sched, bool FP8 = false>
__device__ __forceinline__ void gemm_phase(const int tid, LAS unsigned char* lds, const void* Ab, const void* Btb, const int KB_in, const Sched S, const Epi E) {
    int KB = KB_in; asm volatile("" : "+s"(KB));
    const int wid = __builtin_amdgcn_readfirstlane(tid >> 6), lane = tid & 63, wr = wid >> 2, wc = wid & 3, fr = lane & 15, fq = lane >> 4;
    const int nt = KB / (BK * 2);
    constexpr bool GATHER = Sched::GATHER;
    unsigned voffB[2], va[GATHER ? 2 : 1][2];
#pragma unroll
    for (int i = 0; i < 2; ++i) { int R, C; stage_rc(tid * 16 + i * 8192, R, C); const int Rb = (R & ~31) + perm32(R & 31); voffB[i] = (unsigned)(Rb * KB) + (unsigned)C * 2u;
        if constexpr (!GATHER) va[0][i] = (unsigned)R * S.pitchB + S.colB + (unsigned)C * 2u; }
    const size_t kstep = (size_t)(BK * 2);
    const size_t hstepB = (size_t)HALF * KB;
    const size_t tstepB = 2 * hstepB;
    const unsigned ldsw = (unsigned)wid * 1024u;
    const unsigned lds0 = (unsigned)(unsigned long long)lds;
    const int aoffL = lds_byte(wr * 64 + fr, fq * 8), boffL = lds_byte(wc * 32 + fr, fq * 8);
#define PG8_SA(b, h) (((b) * 2 + (h)) * HTB)
#define PG8_SB(b, h) ((4 + (b) * 2 + (h)) * HTB)
#define PG8_GLDS(sbase, voff, ldsdst) do { unsigned keep_; asm volatile("s_mov_b32 %0, m0\n\ts_mov_b32 m0, %3\n\ts_nop 0\n\tglobal_load_lds_dwordx4 %1, %2\n\ts_mov_b32 m0, %0" \
        : "=&s"(keep_) : "v"(voff), "s"(sbase), "s"(ldsdst) : "memory"); } while (0)
#define PG8_STAGE_B(bufoff, gbase) do { _Pragma("unroll") for (int _i = 0; _i < 2; ++_i) \
        PG8_GLDS((const char*)(gbase), voffB[_i], lds0 + (unsigned)(bufoff) + ldsw + (unsigned)_i * 8192u); } while (0)
#define PG8_STAGE_A(bufoff, kb, h) do { _Pragma("unroll") for (int _i = 0; _i < 2; ++_i) \
        PG8_GLDS(cA + (GATHER ? (size_t)0 : (size_t)(h) * hstepA) + (size_t)(kb), va[GATHER ? (h) : 0][_i], lds0 + (unsigned)(bufoff) + ldsw + (unsigned)_i * 8192u); } while (0)
#define PG8_LD8(p) __builtin_shufflevector(*(const LAS v4i_t*)(p), *(const LAS v4i_t*)((p) + 1024), 0, 1, 2, 3, 4, 5, 6, 7)
#define PG8_LDA(dst, b, h) do { _Pragma("unroll") for (int m = 0; m < 4; ++m) dst[m] = PG8_LD8(lds + PG8_SA(b, h) + aoffL + m * 2048); } while (0)
#define PG8_LDB(dst, b, h) do { _Pragma("unroll") for (int n = 0; n < 2; ++n) dst[n] = PG8_LD8(lds + PG8_SB(b, h) + boffL + n * 2048); } while (0)
#define PG8_HALF(x, k) __builtin_bit_cast(bf16x8, __builtin_shufflevector((x), (x), 4 * (k), 4 * (k) + 1, 4 * (k) + 2, 4 * (k) + 3))
#define PG8_MMA(ai, bj, At, Bt) do { if (GEMM_PRIO == 1) __builtin_amdgcn_s_setprio(1); _Pragma("unroll") for (int m = 0; m < 4; ++m) _Pragma("unroll") for (int n = 0; n < 2; ++n) { \
        if constexpr (FP8) acc[ai][bj][m][n] = __builtin_amdgcn_mfma_scale_f32_16x16x128_f8f6f4(Bt[n], At[m], acc[ai][bj][m][n], 0, 0, 0, one_scale, 0, one_scale); \
        else { acc[ai][bj][m][n] = __builtin_amdgcn_mfma_f32_16x16x32_bf16(PG8_HALF(Bt[n], 0), PG8_HALF(At[m], 0), acc[ai][bj][m][n], 0, 0, 0); \
               acc[ai][bj][m][n] = __builtin_amdgcn_mfma_f32_16x16x32_bf16(PG8_HALF(Bt[n], 1), PG8_HALF(At[m], 1), acc[ai][bj][m][n], 0, 0, 0); } } \
        if (GEMM_PRIO == 1) __builtin_amdgcn_s_setprio(0); } while (0)
#define PG8_MMA_Z0(ai, bj, At, Bt) do { if (GEMM_PRIO == 1) __builtin_amdgcn_s_setprio(1); _Pragma("unroll") for (int m = 0; m < 4; ++m) _Pragma("unroll") for (int n = 0; n < 2; ++n) { \
        if constexpr (FP8) acc[ai][bj][m][n] = __builtin_amdgcn_mfma_scale_f32_16x16x128_f8f6f4(Bt[n], At[m], (f32x4){0.f, 0.f, 0.f, 0.f}, 0, 0, 0, one_scale, 0, one_scale); \
        else { acc[ai][bj][m][n] = __builtin_amdgcn_mfma_f32_16x16x32_bf16(PG8_HALF(Bt[n], 0), PG8_HALF(At[m], 0), (f32x4){0.f, 0.f, 0.f, 0.f}, 0, 0, 0); \
               acc[ai][bj][m][n] = __builtin_amdgcn_mfma_f32_16x16x32_bf16(PG8_HALF(Bt[n], 1), PG8_HALF(At[m], 1), acc[ai][bj][m][n], 0, 0, 0); } } \
        if (GEMM_PRIO == 1) __builtin_amdgcn_s_setprio(0); } while (0)
#define PG8_MMA_H(ai, bj, At, Bt, H0, H2) do { if (GEMM_PRIO == 1) __builtin_amdgcn_s_setprio(1); _Pragma("unroll") for (int m = 0; m < 4; ++m) { _Pragma("unroll") for (int n = 0; n < 2; ++n) { \
        if constexpr (FP8) acc[ai][bj][m][n] = __builtin_amdgcn_mfma_scale_f32_16x16x128_f8f6f4(Bt[n], At[m], acc[ai][bj][m][n], 0, 0, 0, one_scale, 0, one_scale); \
        else { acc[ai][bj][m][n] = __builtin_amdgcn_mfma_f32_16x16x32_bf16(PG8_HALF(Bt[n], 0), PG8_HALF(At[m], 0), acc[ai][bj][m][n], 0, 0, 0); \
               acc[ai][bj][m][n] = __builtin_amdgcn_mfma_f32_16x16x32_bf16(PG8_HALF(Bt[n], 1), PG8_HALF(At[m], 1), acc[ai][bj][m][n], 0, 0, 0); } } \
        if (m == 0) { __builtin_amdgcn_sched_barrier(0); H0; __builtin_amdgcn_sched_barrier(0); } if (m == 2) { __builtin_amdgcn_sched_barrier(0); H2; __builtin_amdgcn_sched_barrier(0); } } \
        if (GEMM_PRIO == 1) __builtin_amdgcn_s_setprio(0); } while (0)
#define PG8_WAIT_V(n) asm volatile("s_waitcnt vmcnt(" #n ")" ::: "memory")
#define PG8_WAIT_L(n) asm volatile("s_waitcnt lgkmcnt(" #n ")" ::: "memory")
#define PG8_BAR __builtin_amdgcn_s_barrier()
#define PG8_SCHED __builtin_amdgcn_sched_barrier(0)
#define PG8_ROWS(u, slot) do { if constexpr (GATHER) { int tt_ = tid; asm volatile("" : "+v"(tt_)); _Pragma("unroll") for (int i = 0; i < 2; ++i) { int R_, C_; stage_rc(tt_ * 16 + i * 8192, R_, C_); \
        _Pragma("unroll") for (int h = 0; h < 2; ++h) va[h][i] = S.aoff(u, h * HALF + R_, slot) + (unsigned)C_ * 2u; } } } while (0)
    int one_scale = 0x7f7f7f7f; asm volatile("" : "+v"(one_scale));
    Unit cur, nxt; int ui = 0;
    if (!S.next(0, cur)) return;
    if (GEMM_PRIO == 2 && wr == 1) __builtin_amdgcn_s_setprio(1);
    S.prefetch(wid, cur, 0);
    PG8_WAIT_V(0); __syncthreads();
    const size_t hstepA = GATHER ? 0 : (size_t)HALF * S.pitchB;
    const char* cA = (const char*)Ab + (GATHER ? (size_t)0 : (size_t)cur.pm * 2 * hstepA);
    PG8_ROWS(cur, 0);
    f32x4 acc[2][2][4][2];
    if constexpr (Epi::KSCALE) {
#pragma unroll
        for (int a = 0; a < 2; ++a)
#pragma unroll
            for (int b = 0; b < 2; ++b)
#pragma unroll
                for (int m = 0; m < 4; ++m)
#pragma unroll
                    for (int n = 0; n < 2; ++n) acc[a][b][m][n] = (f32x4){0.f, 0.f, 0.f, 0.f}; }
    v8i_t At[4], B0[2], B1[2];
    const char* cB = (const char*)Btb + (size_t)cur.pn * tstepB;
    PG8_STAGE_B(PG8_SB(0, 0), cB); PG8_STAGE_B(PG8_SB(0, 1), cB + hstepB); PG8_STAGE_A(PG8_SA(0, 0), 0, 0); PG8_STAGE_A(PG8_SA(0, 1), 0, 1);
    if (wr == 1) PG8_BAR;
    PG8_WAIT_V(2); PG8_BAR;
    PG8_STAGE_B(PG8_SB(1, 0), cB + kstep); PG8_STAGE_A(PG8_SA(1, 0), kstep, 0); PG8_STAGE_B(PG8_SB(1, 1), cB + hstepB + kstep);
    PG8_WAIT_V(6); PG8_BAR;
    for (;;) {
        const bool has_next = S.next(ui + 1, nxt);
        const int slot_c = ui % 3, slot_n = (ui + 1) % 3;
        if (has_next) S.prefetch(wid, nxt, slot_n);
        const char* nB = has_next ? (const char*)Btb + (size_t)nxt.pn * tstepB : cB;
        const char* nA = (has_next && !GATHER) ? (const char*)Ab + (size_t)nxt.pm * 2 * hstepA : cA;
        float kf[Epi::KSCALE ? 2 : 1][2][4];
        if constexpr (Epi::KSCALE) E.kfactors(cur, wr, lane & 15, kf);
        const bool nv0 = cur.nvalid > wr * 64, nv1 = cur.nvalid > HALF + wr * 64;
#define PG8_KPAIR(MM0, ZE) do { \
            const bool last = (t == nt - 2); \
            const size_t ka1 = (size_t)(t + 1) * kstep; \
            const size_t ka2 = last ? 0 : (size_t)(t + 2) * kstep, ka3 = ka2 + kstep; \
            const char* b2 = last ? nB : cB + (size_t)(t + 2) * kstep; const char* b3 = b2 + kstep; \
              \
            PG8_LDB(B0, 0, 0); PG8_LDB(B1, 0, 1); PG8_SCHED; PG8_LDA(At, 0, 0); PG8_STAGE_A(PG8_SA(1, 1), ka1, 1); \
            PG8_WAIT_V(8); PG8_WAIT_L(0); PG8_BAR; if (nv0) { MM0(0, 0, At, B0); MM0(0, 1, At, B1); } else { ZE(0); } PG8_BAR; PG8_SCHED; \
            if (last) {             \
                cA = nA; \
                if (has_next) PG8_ROWS(nxt, slot_n); \
            } \
              \
            PG8_LDA(At, 0, 1); PG8_STAGE_B(PG8_SB(0, 0), b2); PG8_STAGE_B(PG8_SB(0, 1), b2 + hstepB); PG8_STAGE_A(PG8_SA(0, 0), ka2, 0); \
            PG8_WAIT_V(8); PG8_WAIT_L(0); PG8_BAR; if (nv1) { MM0(1, 0, At, B0); MM0(1, 1, At, B1); } else { ZE(1); } PG8_BAR; PG8_SCHED; \
              \
            PG8_LDB(B0, 1, 0); PG8_LDB(B1, 1, 1); PG8_SCHED; PG8_LDA(At, 1, 0); PG8_STAGE_A(PG8_SA(0, 1), ka2, 1); \
            PG8_WAIT_V(8); PG8_WAIT_L(0); PG8_BAR; if (nv0) { PG8_MMA(0, 0, At, B0); PG8_MMA(0, 1, At, B1); } PG8_BAR; PG8_SCHED; \
              \
            PG8_LDA(At, 1, 1); PG8_STAGE_B(PG8_SB(1, 0), b3); PG8_STAGE_B(PG8_SB(1, 1), b3 + hstepB); PG8_STAGE_A(PG8_SA(1, 0), ka3, 0); \
            PG8_WAIT_V(8); PG8_WAIT_L(0); PG8_BAR; if (nv1) { PG8_MMA(1, 0, At, B0); PG8_MMA(1, 1, At, B1); } PG8_BAR; PG8_SCHED; \
        } while (0)
#define PG8_NOP(ai) do { } while (0)
#define PG8_ZERO(ai) do { _Pragma("unroll") for (int b_ = 0; b_ < 2; ++b_) _Pragma("unroll") for (int m_ = 0; m_ < 4; ++m_) _Pragma("unroll") for (int n_ = 0; n_ < 2; ++n_) acc[ai][b_][m_][n_] = (f32x4){0.f, 0.f, 0.f, 0.f}; } while (0)
        static_assert(!DMA_IN_MMA, "the DMA_IN_MMA form of the K-loop was removed with the accumulator-zeroing change");
        if constexpr (!Epi::KSCALE) { const int t = 0; PG8_KPAIR(PG8_MMA_Z0, PG8_ZERO); }
        for (int t = Epi::KSCALE ? 0 : 2; t < nt; t += 2) {
            if constexpr (Epi::KSCALE) { if (t == 8 || t == 12) { const int w_ = (t == 8) ? 0 : 1;
#pragma unroll
                for (int a = 0; a < 2; ++a)
#pragma unroll
                    for (int m = 0; m < 4; ++m) { const float f = (w_ == 0) ? kf[0][a][m] : kf[1][a][m];
#pragma unroll
                        for (int b = 0; b < 2; ++b)
#pragma unroll
                            for (int n = 0; n < 2; ++n) acc[a][b][m][n] *= f; } } }
            PG8_KPAIR(PG8_MMA, PG8_NOP);
        }
#undef PG8_KPAIR
#undef PG8_ZERO
#undef PG8_NOP
        if (wr == 0) PG8_BAR;
        { const int l2_ = lane_id();
          E(acc, cur, lds + GEMM_SLOT0 + slot_c * GEMM_SLOT_BYTES, wr, wc, l2_ & 15, l2_ >> 4); }
        if (!has_next) break;
        if constexpr (Epi::KSCALE) {
#pragma unroll
            for (int a = 0; a < 2; ++a)
#pragma unroll
                for (int b = 0; b < 2; ++b)
#pragma unroll
                    for (int m = 0; m < 4; ++m)
#pragma unroll
                        for (int n = 0; n < 2; ++n) acc[a][b][m][n] = (f32x4){0.f, 0.f, 0.f, 0.f}; }
        cur = nxt; cB = nB; ++ui;
        if (wr == 1) PG8_BAR;
    }
    PG8_WAIT_V(0);
    PG8_BAR;
    if (GEMM_PRIO == 2) __builtin_amdgcn_s_setprio(0);
#undef PG8_SA
#undef PG8_SB
#undef PG8_STAGE_A
#undef PG8_GLDS
#undef PG8_STAGE_B
#undef PG8_LDA
#undef PG8_LDB
#undef PG8_MMA
#undef PG8_MMA_Z0
#undef PG8_MMA_H
#undef PG8_LD8
#undef PG8_HALF
#undef PG8_WAIT_V
#undef PG8_WAIT_L
#undef PG8_BAR
#undef PG8_SCHED
#undef PG8_ROWS
}

struct DenseSched {
    static constexpr bool GATHER = false;
    int nM, nN, nwg, G, c; unsigned pitchB, colB; int deal;
    __device__ __forceinline__ void init(int M, int N, int G_, int c_, unsigned pitch_bytes, unsigned col_bytes) { nM = M / BM; nN = N / BM; nwg = nM * nN; G = G_; c = c_; pitchB = pitch_bytes; colB = col_bytes; deal = 0; }
    __device__ __forceinline__ bool next(int i, Unit& u) const {
        int L = i * G + c;
        if (deal == 1) { if (c < 128) { if (i > 0) return false; } else { if (i > 2) return false; L = (i == 0) ? c : 128 + 128 * i + (c - 128); } }
        if (L >= nwg) return false;
        int wgid = L; { const int q = nwg / NXCD, r = nwg % NXCD, xcd = wgid % NXCD, off = wgid / NXCD; wgid = (xcd < r ? xcd * (q + 1) : r * (q + 1) + (xcd - r) * q) + off; }
        const int nig = WGM * nN, gid = wgid / nig, fm = gid * WGM, gsz = (nM - fm) < WGM ? (nM - fm) : WGM;
        u.pm = fm + ((wgid % nig) % gsz); u.pn = (wgid % nig) / gsz; u.e = 0; u.nvalid = 256; u.mt = 0; return true;
    }
    __device__ __forceinline__ void prefetch(int, const Unit&, int) const {}
    __device__ __forceinline__ unsigned aoff(const Unit& u, int row, int) const { return (unsigned)(u.pm * BM + row) * pitchB + colB; }
};
template <int MODE>
struct MoeSched {
    static constexpr bool GATHER = (MODE == 0);
    static constexpr int mode = MODE;
    unsigned pitchB, colB;
    LAS const int* pst; LAS const int* cn; LAS unsigned char* slots;
    int NT, G, c, P, nunits;
    const int* tok; const float* gate; const float* bias;
    __device__ __forceinline__ bool next(int i, Unit& u) const {
        const int L = i * G + c; if (L >= nunits) return false;
        const int ln_ = lane_id();
        const int tA_ = pst[ln_ & 63], tB_ = pst[128 + (ln_ & 63)], tC_ = cn[ln_ & 31];
        const int PA = __builtin_amdgcn_readlane(tA_, 32), nA = PA * NT;
        int p, pnl, e = 0, mt, nv;
        if (L < nA) {
            int wgid = L; { const int q = nA / NXCD, r = nA % NXCD, xcd = wgid % NXCD, off = wgid / NXCD; wgid = (xcd < r ? xcd * (q + 1) : r * (q + 1) + (xcd - r) * q) + off; }
            const int nig = WGM * NT, gid = wgid / nig, fm = gid * WGM, gsz = (PA - fm) < WGM ? (PA - fm) : WGM;
            p = fm + ((wgid % nig) % gsz); pnl = (wgid % nig) / gsz;
            e = __builtin_popcountll(__builtin_amdgcn_ballot_w64(ln_ >= 1 && ln_ <= 31 && tA_ <= p));
            mt = p - __builtin_amdgcn_readlane(tA_, e); nv = __builtin_amdgcn_readlane(tC_, e) - mt * 256; nv = nv > 256 ? 256 : nv;
        } else {
            const int wb = L - nA, qb = wb / NT; p = PA + qb; pnl = wb % NT;
            e = __builtin_popcountll(__builtin_amdgcn_ballot_w64(ln_ >= 1 && ln_ <= 31 && tB_ <= qb));
            const int ce = __builtin_amdgcn_readlane(tC_, e);
            mt = ce >> 8; nv = ce & 255;
        }
        u.pm = p; u.pn = e * NT + pnl; u.e = e; u.nvalid = nv; u.mt = mt; return true;
    }
    static __device__ __forceinline__ void glds4(const void* sbase_in, unsigned voff, unsigned ldsdst_in) { unsigned keep_;
        const unsigned long long p_ = (unsigned long long)sbase_in;
        const unsigned long long sbase = ((unsigned long long)(unsigned)__builtin_amdgcn_readfirstlane((int)(p_ >> 32)) << 32) | (unsigned)__builtin_amdgcn_readfirstlane((int)p_);
        const unsigned ldsdst = (unsigned)__builtin_amdgcn_readfirstlane((int)ldsdst_in);
        asm volatile("s_mov_b32 %0, m0\n\ts_mov_b32 m0, %3\n\ts_nop 0\n\tglobal_load_lds_dword %1, %2\n\ts_mov_b32 m0, %0" : "=&s"(keep_) : "v"(voff), "s"(sbase), "s"(ldsdst) : "memory"); }
    __device__ __forceinline__ void prefetch(const int wid, const Unit& u, int s) const {
        const int lane = lane_id();
        const int mt = u.mt, pnl = u.pn - u.e * NT;
        const unsigned sl = (unsigned)(unsigned long long)slots + (unsigned)s * GEMM_SLOT_BYTES;
        const unsigned lo = (unsigned)lane * 4u;
        if (wid < 4) {
            glds4(tok + (size_t)u.e * NTOK + mt * 256 + wid * 64, lo, sl + wid * 256);
        } else {
            const int w2 = wid - 4;
            if (mode == 0) {
                const int col = (w2 < 2) ? (128 * pnl + 64 * w2) : (1024 + 128 * pnl + 64 * (w2 - 2));
                glds4(bias + (size_t)u.e * 2048 + col, lo, sl + 2048 + w2 * 256);
            } else {
                glds4(gate + (size_t)u.e * NTOK + mt * 256 + w2 * 64, lo, sl + 1024 + w2 * 256);
                glds4(bias + (size_t)u.e * 1024 + 256 * pnl + w2 * 64, lo, sl + 2048 + w2 * 256);
            }
        }
    }
    __device__ __forceinline__ unsigned aoff(const Unit& u, int row, int s) const {
        if (mode == 0) { int t = ((LAS const int*)(slots + s * GEMM_SLOT_BYTES))[row]; t = (row < u.nvalid) ? (t >> 2) : 0; return (unsigned)t * pitchB; }
        return (unsigned)(u.pm * 256 + row) * pitchB;
    }
};

struct EpiStore {
    static constexpr bool KSCALE = false;
    bf16* O; int ldc; const float* rs; int rsi; float sc;
    __device__ __forceinline__ void operator()(const f32x4 (&acc)[2][2][4][2], const Unit& u, LAS unsigned char*, int wr, int wc, int fr, int fq) const {
        const int row0 = u.pm * BM + wr * 64 + fr, col0 = u.pn * BM + wc * 32 + 8 * fq;
#pragma unroll
        for (int ai = 0; ai < 2; ++ai)
#pragma unroll
            for (int m = 0; m < 4; ++m) {
                const int row = row0 + ai * HALF + m * 16; float s = sc;
                if (rs) { if (PREP_FUSED) { const f32x4 p = *(const f32x4*)(rs + (size_t)row * 8 + 4); s *= rsqrtf(((p[0] + p[1]) + (p[2] + p[3])) * (1.f / 128.f) + RMS_EPS); } else s *= rs[row * 2 + rsi]; }
                bf16* rowp = O + (size_t)row * ldc + col0;
#pragma unroll
                for (int bj = 0; bj < 2; ++bj) { const f32x4 v0 = acc[ai][bj][m][0] * s, v1 = acc[ai][bj][m][1] * s;
                    u32x4 w; w.x = cvtpk(v0[0], v0[1]); w.y = cvtpk(v0[2], v0[3]); w.z = cvtpk(v1[0], v1[1]); w.w = cvtpk(v1[2], v1[3]);
                    *(u32x4*)(rowp + bj * HALF) = w; }
            }
    }
};
struct EpiProj {
    static constexpr bool KSCALE = false;
    unsigned char* wsb; float sc;
    __device__ __forceinline__ void operator()(const f32x4 (&acc)[2][2][4][2], const Unit& u, LAS unsigned char*, int wr, int wc, int fr, int fq) const {
        bf16* const O = (bf16*)(wsb + WS_PROJ); constexpr int ldc = NPROJ; float* const pst = (float*)(wsb + WS_RSTD); const f32x2* const cs = (const f32x2*)(wsb + WS_ROPE); bf16* const kpe = (bf16*)(wsb + WS_KPE);
        const int row0 = u.pm * BM + wr * 64 + fr, col0 = u.pn * BM + wc * 32 + 8 * fq, lane = fr + 16 * fq;
        float rs8[8];
#pragma unroll
        for (int i = 0; i < 8; ++i) rs8[i] = NORM_FOLD ? ((const float*)(wsb + WS_RSIN))[row0 + (i >> 2) * HALF + (i & 3) * 16] * sc : sc;
#pragma unroll
        for (int ai = 0; ai < 2; ++ai)
#pragma unroll
            for (int m = 0; m < 4; ++m) {
                const int row = row0 + ai * HALF + m * 16; const float sc = rs8[ai * 4 + m];
                bf16* rowp = O + (size_t)row * ldc + col0;
#pragma unroll
                for (int bj = 0; bj < 2; ++bj) { const f32x4 v0 = acc[ai][bj][m][0] * sc, v1 = acc[ai][bj][m][1] * sc;
                    u32x4 w; w.x = cvtpk(v0[0], v0[1]); w.y = cvtpk(v0[2], v0[3]); w.z = cvtpk(v1[0], v1[1]); w.w = cvtpk(v1[2], v1[3]);
                    *(u32x4*)(rowp + bj * HALF) = w; }
                if (u.pn <= 1) {
                    float ss = 0.f;
#pragma unroll
                    for (int bj = 0; bj < 2; ++bj) if (u.pn == 0 || bj == 0) {
#pragma unroll
                        for (int n = 0; n < 2; ++n) { const f32x4 v = acc[ai][bj][m][n] * sc; ss += (v[0] * v[0] + v[1] * v[1]) + (v[2] * v[2] + v[3] * v[3]); } }
                    ss += shx(ss, lane, 16); ss += shx(ss, lane, 32);
                    if (fq == 0) pst[(size_t)row * 8 + 4 * u.pn + wc] = ss;
                    if (u.pn == 1 && wc == 0) {
                        const f32x4 v0 = acc[ai][1][m][0] * sc, v1 = acc[ai][1][m][1] * sc; const f32x2* c4 = cs + (size_t)row * 16 + 4 * fq;
                        const f32x2 c0 = c4[0], c1 = c4[1], c2 = c4[2], c3 = c4[3];
                        u32x4 w; w.x = cvtpk(v0[0] * c0.x - v0[1] * c0.y, v0[1] * c0.x + v0[0] * c0.y); w.y = cvtpk(v0[2] * c1.x - v0[3] * c1.y, v0[3] * c1.x + v0[2] * c1.y);
                        w.z = cvtpk(v1[0] * c2.x - v1[1] * c2.y, v1[1] * c2.x + v1[0] * c2.y); w.w = cvtpk(v1[2] * c3.x - v1[3] * c3.y, v1[3] * c3.x + v1[2] * c3.y);
                        *(u32x4*)(kpe + (size_t)row * 32 + 8 * fq) = w; }
                }
                asm volatile("" ::: "memory");
            }
    }
};
struct EpiQ {
    static constexpr bool KSCALE = false;
    bf16* O; const float* rs; const f32x2* cs;
    struct In { f32x4 p; f32x2 c[2][4]; };
    __device__ __forceinline__ void load(In& in, int row, int i0a, int i0b) const {
        in.p = *(const f32x4*)(rs + (size_t)row * 8);
        const f32x2* ca = cs + (size_t)row * 16 + i0a; const f32x2* cb = cs + (size_t)row * 16 + i0b;
#pragma unroll
        for (int j = 0; j < 4; ++j) { in.c[0][j] = ca[j]; in.c[1][j] = cb[j]; }
    }
    __device__ __forceinline__ void operator()(const f32x4 (&acc)[2][2][4][2], const Unit& u, LAS unsigned char*, int wr, int wc, int fr, int fq) const {
        const int row0 = u.pm * BM + wr * 64 + fr, col0 = u.pn * BM + wc * 32 + 8 * fq;
        const int hd0 = col0 % 96, hd1 = (col0 + HALF) % 96;
        const int i0a = (hd0 >= 64) ? ((hd0 - 64) >> 1) : 0, i0b = (hd1 >= 64) ? ((hd1 - 64) >> 1) : 0;
        In cur, nxt; load(cur, row0, i0a, i0b); nxt = cur;
#pragma unroll
        for (int i = 0; i < 8; ++i) { const int ai = i >> 2, m = i & 3;
            const int row = row0 + ai * HALF + m * 16;
            if (i < 7) load(nxt, row0 + ((i + 1) >> 2) * HALF + ((i + 1) & 3) * 16, i0a, i0b);
            asm volatile("" ::: "memory");
            const float s = rsqrtf(((cur.p[0] + cur.p[1]) + (cur.p[2] + cur.p[3])) * (1.f / 256.f) + RMS_EPS);
            bf16* rowp = O + (size_t)row * 768 + col0;
#pragma unroll
            for (int bj = 0; bj < 2; ++bj) { f32x4 v0 = acc[ai][bj][m][0] * s, v1 = acc[ai][bj][m][1] * s;
                if ((bj ? hd1 : hd0) >= 64) { const f32x2 c0 = cur.c[bj][0], c1 = cur.c[bj][1], c2 = cur.c[bj][2], c3 = cur.c[bj][3];
                    f32x4 a, b;
                    a[0] = v0[0] * c0.x - v0[1] * c0.y; a[1] = v0[1] * c0.x + v0[0] * c0.y; a[2] = v0[2] * c1.x - v0[3] * c1.y; a[3] = v0[3] * c1.x + v0[2] * c1.y;
                    b[0] = v1[0] * c2.x - v1[1] * c2.y; b[1] = v1[1] * c2.x + v1[0] * c2.y; b[2] = v1[2] * c3.x - v1[3] * c3.y; b[3] = v1[3] * c3.x + v1[2] * c3.y;
                    v0 = a; v1 = b; }
                u32x4 w; w.x = cvtpk(v0[0], v0[1]); w.y = cvtpk(v0[2], v0[3]); w.z = cvtpk(v1[0], v1[1]); w.w = cvtpk(v1[2], v1[3]);
                *(u32x4*)(rowp + bj * HALF) = w; }
            asm volatile("" ::: "memory");
            cur = nxt;
        }
    }
};
struct EpiResid {
    static constexpr bool KSCALE = false;
    const float* xin32; bf16* r16; float sc;
    __device__ __forceinline__ void operator()(const f32x4 (&acc)[2][2][4][2], const Unit& u, LAS unsigned char*, int wr, int wc, int fr, int fq) const {
        const int row0 = u.pm * BM + wr * 64 + fr, col0 = u.pn * BM + wc * 32 + 8 * fq;
#pragma unroll
        for (int ai = 0; ai < 2; ++ai)
#pragma unroll
            for (int m = 0; m < 4; ++m) {
                const size_t ro = (size_t)(row0 + ai * HALF + m * 16) * DM + col0;
#pragma unroll
                for (int bj = 0; bj < 2; ++bj) {
                    f32x4 x0, x1;
                    if (xin32) { x0 = *(const f32x4*)(xin32 + ro + bj * HALF); x1 = *(const f32x4*)(xin32 + ro + bj * HALF + 4); }
                    else { const u32x4 y = *(const u32x4*)(r16 + ro + bj * HALF); x0 = (f32x4){bf_lo(y.x), bf_hi(y.x), bf_lo(y.y), bf_hi(y.y)}; x1 = (f32x4){bf_lo(y.z), bf_hi(y.z), bf_lo(y.w), bf_hi(y.w)}; }
                    x0 += acc[ai][bj][m][0] * sc; x1 += acc[ai][bj][m][1] * sc;
                    *(u32x4*)(r16 + ro + bj * HALF) = (u32x4){cvtpk(x0[0], x0[1]), cvtpk(x0[2], x0[3]), cvtpk(x1[0], x1[1]), cvtpk(x1[2], x1[3])}; }
                asm volatile("" ::: "memory");
            }
    }
};
struct EpiResidNorm {
    static constexpr bool KSCALE = true;
    const float* xin32; bf16* r16; const float* st;
    __device__ __forceinline__ void kfactors(const Unit& u, int wr, int fr, float (&kf)[2][2][4]) const {
#pragma unroll
        for (int ai = 0; ai < 2; ++ai)
#pragma unroll
            for (int m = 0; m < 4; ++m) { const f32x4* q = (const f32x4*)(st + (size_t)(u.pm * BM + ai * HALF + wr * 64 + m * 16 + fr) * 16);
                const f32x4 q0 = q[0], q1 = q[1], q2 = q[2], q3 = q[3];
                const float sa = ((q0[0] + q0[1]) + (q0[2] + q0[3])) + ((q1[0] + q1[1]) + (q1[2] + q1[3])), sb = (q2[0] + q2[1]) + (q2[2] + q2[3]), sc = (q3[0] + q3[1]) + (q3[2] + q3[3]);
                const float ra = rsqrtf(sa * (1.f / 512.f) + RMS_EPS), rb = rsqrtf(sb * (1.f / 256.f) + RMS_EPS), rc = rsqrtf(sc * (1.f / 256.f) + RMS_EPS);
                kf[0][ai][m] = ra / rb; kf[1][ai][m] = rb / rc; }
    }
    struct In { f32x4 q3; u32x4 y[2]; f32x4 x[4]; };
    __device__ __forceinline__ void load(In& in, int row, int col0) const { const size_t ro = (size_t)row * DM + col0;
        in.q3 = *(const f32x4*)(st + (size_t)row * 16 + 12);
        if (xin32) { in.x[0] = *(const f32x4*)(xin32 + ro); in.x[1] = *(const f32x4*)(xin32 + ro + 4); in.x[2] = *(const f32x4*)(xin32 + ro + HALF); in.x[3] = *(const f32x4*)(xin32 + ro + HALF + 4); }
        else { in.y[0] = *(const u32x4*)(r16 + ro); in.y[1] = *(const u32x4*)(r16 + ro + HALF); }
    }
    __device__ __forceinline__ void operator()(const f32x4 (&acc)[2][2][4][2], const Unit& u, LAS unsigned char*, int wr, int wc, int fr, int fq) const {
        const int row0 = u.pm * BM + wr * 64 + fr, col0 = u.pn * BM + wc * 32 + 8 * fq;
        In cur, nxt; load(cur, row0, col0); nxt = cur;
#pragma unroll
        for (int i = 0; i < 8; ++i) { const int ai = i >> 2, m = i & 3;
            const int row = row0 + ai * HALF + m * 16; const size_t ro = (size_t)row * DM + col0;
            if (i < 7) load(nxt, row0 + ((i + 1) >> 2) * HALF + ((i + 1) & 3) * 16, col0);
            asm volatile("" ::: "memory");
            const float rc = rsqrtf(((cur.q3[0] + cur.q3[1]) + (cur.q3[2] + cur.q3[3])) * (1.f / 256.f) + RMS_EPS);
#pragma unroll
            for (int bj = 0; bj < 2; ++bj) {
                f32x4 x0, x1;
                if (xin32) { x0 = cur.x[2 * bj]; x1 = cur.x[2 * bj + 1]; }
                else { const u32x4 y = cur.y[bj]; x0 = (f32x4){bf_lo(y.x), bf_hi(y.x), bf_lo(y.y), bf_hi(y.y)}; x1 = (f32x4){bf_lo(y.z), bf_hi(y.z), bf_lo(y.w), bf_hi(y.w)}; }
                x0 += acc[ai][bj][m][0] * rc; x1 += acc[ai][bj][m][1] * rc;
                *(u32x4*)(r16 + ro + bj * HALF) = (u32x4){cvtpk(x0[0], x0[1]), cvtpk(x0[2], x0[3]), cvtpk(x1[0], x1[1]), cvtpk(x1[2], x1[3])}; }
            asm volatile("" ::: "memory");
            cur = nxt;
        }
    }
};
struct EpiSwiglu {
    static constexpr bool KSCALE = false;
    unsigned char* O; int NT; float ascale_inv, oscale;
    __device__ __forceinline__ void operator()(const f32x4 (&acc)[2][2][4][2], const Unit& u, LAS unsigned char* sl, int wr, int wc, int fr, int fq) const {
        const int pnl = u.pn - u.e * NT; const int cw = wc * 32 + 8 * fq;
        const LAS float* bs = (const LAS float*)(sl + 2048);
        f32x4 bg[2], bu[2];
#pragma unroll
        for (int n = 0; n < 2; ++n) { bg[n] = *(const LAS f32x4*)(bs + cw + 4 * n); bu[n] = *(const LAS f32x4*)(bs + 128 + cw + 4 * n); }
#pragma unroll
        for (int ai = 0; ai < 2; ++ai)
#pragma unroll
            for (int m = 0; m < 4; ++m) {
                const int rt = ai * HALF + wr * 64 + m * 16 + fr;
                unsigned w[4];
#pragma unroll
                for (int n = 0; n < 2; ++n) { float a[4];
#pragma unroll
                    for (int h2 = 0; h2 < 2; ++h2) {
                        const f32x2 ga = {acc[ai][0][m][n][2 * h2], acc[ai][0][m][n][2 * h2 + 1]}, ua = {acc[ai][1][m][n][2 * h2], acc[ai][1][m][n][2 * h2 + 1]};
                        const f32x2 gb = {bg[n][2 * h2], bg[n][2 * h2 + 1]}, ub = {bu[n][2 * h2], bu[n][2 * h2 + 1]};
                        f32x2 g2 = ga * ascale_inv + gb, u2 = ua * ascale_inv + ub;
                        g2.x = __builtin_amdgcn_fmed3f(g2.x, -25.f, 7.f); g2.y = __builtin_amdgcn_fmed3f(g2.y, -25.f, 7.f); u2.x = __builtin_amdgcn_fmed3f(u2.x, -7.f, 7.f); u2.y = __builtin_amdgcn_fmed3f(u2.y, -7.f, 7.f);
                        const f32x2 t2 = g2 * (-1.702f * LOG2E);
                        f32x2 e2; e2.x = ex2(t2.x); e2.y = ex2(t2.y);
                        const f32x2 d2 = e2 + 1.f;
                        const float rr = __builtin_amdgcn_rcpf(d2.x * d2.y);
                        const f32x2 r2 = (f32x2){d2.y, d2.x} * rr;
                        const f32x2 o2 = (u2 * oscale + oscale) * (g2 * r2);
                        a[2 * h2] = o2.x; a[2 * h2 + 1] = o2.y; }
                    if (DN_FP8) w[n] = pk4_fp8(a[0], a[1], a[2], a[3]); else { w[2 * n] = cvtpk(a[0], a[1]); w[2 * n + 1] = cvtpk(a[2], a[3]); } }
                if (DN_FP8) *(u32x2*)(O + (size_t)(u.pm * 256 + rt) * 1024 + 128 * pnl + cw) = (u32x2){w[0], w[1]};
                else *(u32x4*)((bf16*)O + (size_t)(u.pm * 256 + rt) * 1024 + 128 * pnl + cw) = (u32x4){w[0], w[1], w[2], w[3]};
                asm volatile("" ::: "memory");
            }
    }
};
struct EpiDown {
    static constexpr bool KSCALE = false;
    bf16* YS; int NT; float ascale_inv;
    __device__ __forceinline__ void operator()(const f32x4 (&acc)[2][2][4][2], const Unit& u, LAS unsigned char* sl, int wr, int wc, int fr, int fq) const {
        const int pnl = u.pn - u.e * NT; const int cw = wc * 32 + 8 * fq;
        const LAS int* tk = (const LAS int*)sl; const LAS float* gt = (const LAS float*)(sl + 1024); const LAS float* bs = (const LAS float*)(sl + 2048);
        f32x4 bb[2][2];
#pragma unroll
        for (int bj = 0; bj < 2; ++bj)
#pragma unroll
            for (int n = 0; n < 2; ++n) bb[bj][n] = *(const LAS f32x4*)(bs + bj * HALF + cw + 4 * n);
#pragma unroll
        for (int ai = 0; ai < 2; ++ai)
#pragma unroll
            for (int m = 0; m < 4; ++m) {
                const int rt = ai * HALF + wr * 64 + m * 16 + fr;
                if (rt < u.nvalid) {
                    const int slot = tk[rt]; const float g = gt[rt];
                    bf16* rowp = YS + (size_t)slot * 1024 + 256 * pnl + cw; unsigned char* rowp8 = (unsigned char*)YS + (size_t)slot * 1024 + 256 * pnl + cw;
#pragma unroll
                    for (int bj = 0; bj < 2; ++bj) { const f32x4 v0 = (acc[ai][bj][m][0] * ascale_inv + bb[bj][0]) * g, v1 = (acc[ai][bj][m][1] * ascale_inv + bb[bj][1]) * g;
                        if (YS_FP8) { *(u32x2*)(rowp8 + bj * HALF) = (u32x2){pk4_fp8_scaled(v0[0], v0[1], v0[2], v0[3], 1.f / YS_SCALE), pk4_fp8_scaled(v1[0], v1[1], v1[2], v1[3], 1.f / YS_SCALE)}; }
                        else { u32x4 w; w.x = cvtpk(v0[0], v0[1]); w.y = cvtpk(v0[2], v0[3]); w.z = cvtpk(v1[0], v1[1]); w.w = cvtpk(v1[2], v1[3]);
                            *(u32x4*)(rowp + bj * HALF) = w; } }
                }
                asm volatile("" ::: "memory");
            }
    }
};
}

__device__ __forceinline__ int crow(int r, int hi) { return (r & 3) + 8 * (r >> 2) + 4 * hi; }
__device__ __forceinline__ bf16x8 pack8(const f32x16& x, int s) {
    u32x4 p; p.x = cvtpk(x[8 * s], x[8 * s + 1]); p.y = cvtpk(x[8 * s + 2], x[8 * s + 3]); p.z = cvtpk(x[8 * s + 4], x[8 * s + 5]); p.w = cvtpk(x[8 * s + 6], x[8 * s + 7]);
    return __builtin_bit_cast(bf16x8, p);
}
__device__ __forceinline__ s16x4 vtr(LAS const unsigned char* p) { return __builtin_bit_cast(s16x4, __builtin_amdgcn_ds_read_tr16_b64_v4i16((LAS v4i16_t*)p)); }

__device__ __forceinline__ void glds16s(const void* sbase, unsigned voff, unsigned ldsdst) { unsigned keep_;
    asm volatile("s_mov_b32 %0, m0\n\ts_mov_b32 m0, %3\n\ts_nop 0\n\tglobal_load_lds_dwordx4 %1, %2 nt\n\ts_mov_b32 m0, %0" : "=&s"(keep_) : "v"(voff), "s"(sbase), "s"(ldsdst) : "memory"); }
struct BgConv {
    const float* wgu; const float* wdn; unsigned char* gu8; unsigned char* dn8;
    unsigned lds_scr; int next, stride, total, pend, tick;
    static constexpr int NGU = NEXP * 16 * 64, NDN = NEXP * 16 * 32;
    __device__ __forceinline__ void locate(int item, const float*& W, unsigned char*& WT, int& N, int& k0, int& n0, bool& gu) const {
        gu = item < NGU;
        if (gu) { const int mi = item >> 10, r = item & 1023; N = 2048; W = wgu + (size_t)mi * 1024 * 2048; WT = gu8 + (size_t)mi * 2048 * 1024; k0 = 64 * (r >> 6); n0 = 32 * (r & 63); }
        else { const int i2 = item - NGU, mi = i2 >> 9, r = i2 & 511; N = 1024; W = wdn + (size_t)mi * 1024 * 1024; WT = dn8 + (size_t)mi * 1024 * 1024; k0 = 64 * (r >> 5); n0 = 32 * (r & 31); }
    }
    __device__ __forceinline__ void issue(int item, int lane) const {
        const float* W; unsigned char* WT; int N, k0, n0; bool gu; locate(item, W, WT, N, k0, n0, gu);
        const float* src = W + (size_t)k0 * N + n0;
        const unsigned voff = (unsigned)(((lane >> 3) * N + 4 * (lane & 7)) * 4);
#pragma unroll
        for (int j = 0; j < 8; ++j) glds16s(src + (size_t)j * 8 * N, voff, lds_scr + (unsigned)j * 1024u);
    }
    __device__ __forceinline__ void convert(int item, int lane, LAS const unsigned char* ldsb) const {
        const float* W; unsigned char* WT; int N, k0, n0; bool gu; locate(item, W, WT, N, k0, n0, gu);
        asm volatile("s_waitcnt vmcnt(0)" ::: "memory");
        const LAS float* scr = (const LAS float*)(ldsb + lds_scr);
        const int n = lane & 31, kh = lane >> 5;
        int row = n0 + n; if (gu) row = (row < 1024) ? 256 * (row >> 7) + (row & 127) : 256 * ((row - 1024) >> 7) + 128 + ((row - 1024) & 127);
        unsigned char* dst = WT + (size_t)row * 1024 + k0 + 16 * kh;
#pragma unroll
        for (int h2 = 0; h2 < 2; ++h2) { float v[16];
#pragma unroll
            for (int i = 0; i < 16; ++i) v[i] = scr[(32 * h2 + 16 * kh + i) * 32 + n];
            *(u32x4*)(dst + 32 * h2) = (u32x4){pk4_fp8_scaled(v[0], v[1], v[2], v[3], 1.f / W_SCALE), pk4_fp8_scaled(v[4], v[5], v[6], v[7], 1.f / W_SCALE), pk4_fp8_scaled(v[8], v[9], v[10], v[11], 1.f / W_SCALE), pk4_fp8_scaled(v[12], v[13], v[14], v[15], 1.f / W_SCALE)}; }
        asm volatile("s_waitcnt lgkmcnt(0)" ::: "memory");
    }
    __device__ __forceinline__ void step(int lane, LAS const unsigned char* ldsb) {
        if (++tick < 3) return;
        tick = 0;
        if (pend >= 0) convert(pend, lane, ldsb);
        if (next < total) { issue(next, lane); pend = next; next += stride; } else pend = -1;
    }
    __device__ __forceinline__ void flush(int lane, LAS const unsigned char* ldsb) {
        if (pend >= 0) { convert(pend, lane, ldsb); pend = -1; }
        for (; next < total; next += stride) { issue(next, lane); convert(next, lane, ldsb); }
    }
};

template <int NQF_> struct AttnPre { bf16x8 qf[NQF_]; u32x4 kr0, kr1, vr; bool valid; };
struct AttnNext { const bf16* qsrc; const bf16* k0src; const bf16* vsrc; int rowbase, qblk; bool has; };
template <int KIND>
__device__ __forceinline__ void attn_prefetch(const int tid, AttnPre<(KIND == 0) ? 6 : 4>& pre, const AttnNext nx, const int qpitch, const int k0pitch, const bf16* __restrict__ k1src, const int vpitch) {
    constexpr int DK = (KIND == 0) ? 96 : 64, KCH = DK / 8, NQF = DK / 16;
    const int lane = tid & 63, w = __builtin_amdgcn_readfirstlane(tid >> 6), r32 = lane & 31, hh = lane >> 5;
    const int vrow = tid >> 3, vc = tid & 7, krow0 = tid / KCH, kc0 = tid % KCH, krow1 = (tid + 512) / KCH, kc1 = (tid + 512) % KCH;
    const bf16* qn = nx.qsrc + (size_t)(nx.rowbase + nx.qblk * 256 + 32 * w + r32) * qpitch;
#pragma unroll
    for (int d0 = 0; d0 < NQF; ++d0) pre.qf[d0] = *(const bf16x8*)(qn + 16 * d0 + 8 * hh);
    const int tn = (KIND == 1) ? (4 * nx.qblk + 3) : (KIND == 2) ? ((4 * nx.qblk - 8) > 0 ? (4 * nx.qblk - 8) : 0) : 0;
    const size_t rb_ = (size_t)nx.rowbase + 64 * (size_t)tn;
    pre.kr1 = (u32x4){0u, 0u, 0u, 0u};
    pre.vr = *(const u32x4*)(nx.vsrc + (rb_ + vrow) * vpitch + 8 * vc);
    if (KIND == 0) { pre.kr0 = (kc0 < 8) ? *(const u32x4*)(nx.k0src + (rb_ + krow0) * k0pitch + 8 * kc0) : *(const u32x4*)(k1src + (rb_ + krow0) * 32 + 8 * (kc0 - 8));
        if (tid < 256) pre.kr1 = (kc1 < 8) ? *(const u32x4*)(nx.k0src + (rb_ + krow1) * k0pitch + 8 * kc1) : *(const u32x4*)(k1src + (rb_ + krow1) * 32 + 8 * (kc1 - 8)); }
    else pre.kr0 = *(const u32x4*)(nx.k0src + (rb_ + krow0) * k0pitch + 8 * kc0);
}
template <int KIND>
__device__ __forceinline__ void attn_unit(const int tid, LAS unsigned char* lds, const bf16* __restrict__ qsrc, const int qpitch,
                                          const bf16* __restrict__ k0src, const int k0pitch, const bf16* __restrict__ k1src,
                                          const bf16* __restrict__ vsrc, const int vpitch, bf16* __restrict__ odst,
                                          const float* __restrict__ relb, const int rowbase, const int qblk, float* __restrict__ mstat  , BgConv& bg,
                                          AttnPre<(KIND == 0) ? 6 : 4>& pre, const AttnNext nx) {
    constexpr int DK = (KIND == 0) ? 96 : 64, KCH = DK / 8, KPITCH = DK * 2 + 16, KBYTES = 64 * KPITCH, NQF = DK / 16;
    constexpr int OFF_K = 0, OFF_V = 2 * KBYTES, OFF_BIAS = OFF_V + 2 * 8192, OFF_DONE = OFF_BIAS + 2064;
    const int lane = tid & 63, w = __builtin_amdgcn_readfirstlane(tid >> 6), r32 = lane & 31, hh = lane >> 5;
    const int c = 4 * qblk + (w >> 1);
    const int tq = 32 * (w & 1) + r32;
    const int T1 = 4 * qblk + 3, T0 = (KIND == 2) ? ((4 * qblk - 8) > 0 ? (4 * qblk - 8) : 0) : 0;
    const int nsteps = T1 - T0 + 1;
#define TILE_OF(it) ((KIND == 1) ? (T1 - (it)) : (T0 + (it)))
    const bf16* qrow = qsrc + (size_t)(rowbase + qblk * 256 + 32 * w + r32) * qpitch;
    bf16x8 qf[NQF];
#pragma unroll
    for (int d0 = 0; d0 < NQF; ++d0) qf[d0] = pre.qf[d0];
    (void)qrow;
    const int vrow = tid >> 3, vc = tid & 7;
    const unsigned vlds = (unsigned)(vrow * 128 + (((vc >> 1) ^ (((vrow >> 1) & 1) << 1)) * 32) + (vc & 1) * 16);
    const int krow0 = tid / KCH, kc0 = tid % KCH;
    const int krow1 = (tid + 512) / KCH, kc1 = (tid + 512) % KCH;
    u32x4 kr0, kr1 = (u32x4){0u, 0u, 0u, 0u}, vr;
#define ATT_ISSUE_X(K0, V, RB, tile, KR0, KR1, VR) do { const size_t rb_ = (size_t)(RB) + 64 * (size_t)(tile); \
        VR = *(const u32x4*)((V) + (rb_ + vrow) * vpitch + 8 * vc); \
        if (KIND == 0) { KR0 = (kc0 < 8) ? *(const u32x4*)((K0) + (rb_ + krow0) * k0pitch + 8 * kc0) : *(const u32x4*)(k1src + (rb_ + krow0) * 32 + 8 * (kc0 - 8)); \
            if (tid < 256) KR1 = (kc1 < 8) ? *(const u32x4*)((K0) + (rb_ + krow1) * k0pitch + 8 * kc1) : *(const u32x4*)(k1src + (rb_ + krow1) * 32 + 8 * (kc1 - 8)); } \
        else { KR0 = *(const u32x4*)((K0) + (rb_ + krow0) * k0pitch + 8 * kc0); } } while (0)
#define ATT_ISSUE(tile) ATT_ISSUE_X(k0src, vsrc, rowbase, tile, kr0, kr1, vr)
#define ATT_WRITE(buf) do { *(LAS u32x4*)(lds + OFF_V + (buf) * 8192 + vlds) = vr; \
        *(LAS u32x4*)(lds + OFF_K + (buf) * KBYTES + krow0 * KPITCH + kc0 * 16) = kr0; \
        if (KIND == 0 && tid < 256) *(LAS u32x4*)(lds + OFF_K + (buf) * KBYTES + krow1 * KPITCH + kc1 * 16) = kr1; } while (0)
    f32x16 o[2]; o[0] = (f32x16){}; o[1] = (f32x16){};
    float l_run = 0.f, R = 0.f;
    f32x16 negm = (f32x16){};
    bool started = false;
    bf16x8 tri0, tri1, ones;
#pragma unroll
    for (int j = 0; j < 8; ++j) { const int k0 = 8 * (j >> 2) + 4 * hh + (j & 3); tri0[j] = (k0 > r32) ? (short)0x3F80 : (short)0; tri1[j] = (16 + k0 > r32) ? (short)0x3F80 : (short)0; ones[j] = (short)0x3F80; }
    constexpr int BT_N = 588, BT_BYTES = BT_N * 4;
    if (KIND == 2) { LAS float* bl = (LAS float*)(lds + OFF_BIAS);
        for (int i = tid; i < 4 * BT_N; i += 512) { const int sidx = i / BT_N, x = i - sidx * BT_N; int j = x - sidx; j = j < 0 ? 0 : (j > 512 ? 512 : j); bl[i] = relb[j] * LOG2E; } }
    const unsigned bias_lane = (unsigned)(OFF_BIAS + ((3 - tq) & 3) * BT_BYTES + 4 * (tq + 256 - 4 * hh - 59 + ((3 - tq) & 3)));
    const int g16 = (lane >> 4) & 1, q4 = (lane & 15) >> 2, p4 = lane & 3;
    const unsigned vb0 = (unsigned)((4 * hh + q4) * 128 + (2 * (0 ^ (q4 >> 1)) + g16) * 32 + 8 * p4);
    const unsigned vb1 = (unsigned)((4 * hh + q4) * 128 + (2 * (1 ^ (q4 >> 1)) + g16) * 32 + 8 * p4);
    LAS int* doneit = (LAS int*)(lds + OFF_DONE);
    bool mydone = false;
    if (KIND == 1 && lane == 0) doneit[w] = 0x7fffffff;
    if (w >= 4) __builtin_amdgcn_s_setprio(1);
    kr0 = pre.kr0; kr1 = pre.kr1; vr = pre.vr;
    ATT_WRITE(0);
    if (nsteps > 1) ATT_ISSUE(TILE_OF(1));
    __syncthreads();
    for (int it = 0; it < nsteps; ++it) {
        const int buf = it & 1, tile = TILE_OF(it);
        if (KIND == 1) { const int dv = doneit[lane & 7]; if (__all(dv < it)) break; }
        const bool active = (tile <= c) && (KIND != 2 || tile >= c - 8) && !mydone;
        if (active) {
            LAS const unsigned char* Kb = lds + OFF_K + buf * KBYTES + r32 * KPITCH + 16 * hh;
            f32x16 p0, p1;
            { bf16x8 ka[NQF], kb2[NQF];
#pragma unroll
              for (int d0 = 0; d0 < NQF; ++d0) { ka[d0] = *(const LAS bf16x8*)(Kb + 32 * d0); kb2[d0] = *(const LAS bf16x8*)(Kb + 32 * KPITCH + 32 * d0); }
              __builtin_amdgcn_sched_barrier(0);
              if (KIND == 1) { p0 = (f32x16){}; p1 = (f32x16){}; p0 = MFMA32(ka[0], qf[0], p0); p1 = MFMA32(kb2[0], qf[0], p1); }
              else { p0 = MFMA32(ka[0], qf[0], negm); p1 = MFMA32(kb2[0], qf[0], negm); }
#pragma unroll
              for (int d0 = 1; d0 < NQF; ++d0) { p0 = MFMA32(ka[d0], qf[d0], p0); p1 = MFMA32(kb2[d0], qf[d0], p1); } }
            if (KIND == 1) {
                const bool diag = (tile == c);
                f32x16 lk0, lk1;
#pragma unroll
                for (int r = 0; r < 16; ++r) {
                    const int kv = crow(r, hh);
                    { const float z = p0[r]; const float t = ex2(fminf(z, 80.f)); float lk = -lg2(1.f + t); if (diag && kv >= tq) lk = 0.f; lk0[r] = lk; p0[r] = z + lk; }
                    { const float z = p1[r]; const float t = ex2(fminf(z, 80.f)); float lk = -lg2(1.f + t); if (diag && kv + 32 >= tq) lk = 0.f; lk1[r] = lk; p1[r] = z + lk; }
                }
                const bf16x8 f0 = pack8(lk0, 0), f1 = pack8(lk0, 1), f2 = pack8(lk1, 0), f3 = pack8(lk1, 1);
                f32x16 rv;
#pragma unroll
                for (int r = 0; r < 16; ++r) rv[r] = R;
                f32x16 y0 = MFMA32(tri0, f0, rv); y0 = MFMA32(tri1, f1, y0); y0 = MFMA32(ones, f2, y0); y0 = MFMA32(ones, f3, y0);
                f32x16 y1 = MFMA32(tri0, f2, rv); y1 = MFMA32(tri1, f3, y1);
#pragma unroll
                for (int r = 0; r < 16; ++r) {
                    const int kv = crow(r, hh);
                    float a0 = ex2(p0[r] + y0[r]), a1 = ex2(p1[r] + y1[r]);
                    if (diag && kv >= tq) a0 = 0.f;
                    if (diag && kv + 32 >= tq) a1 = 0.f;
                    p0[r] = a0; p1[r] = a1;
                }
                const float rn = y0[0] + lk0[0];
                R = __builtin_bit_cast(float, __builtin_amdgcn_ds_bpermute(r32 << 2, __builtin_bit_cast(int, rn)));
                if (__all(R < -48.f)) { mydone = true; if (lane == 0) doneit[w] = it; }
            } else {
                if (KIND == 2) {
                    const LAS float* bl = (const LAS float*)(lds + OFF_BIAS);
                    const int dist = c - tile;
                    if (dist >= 5) { const float bc = bl[512];
#pragma unroll
                        for (int r = 0; r < 16; ++r) { p0[r] += bc; p1[r] += bc; } }
                    else { LAS const unsigned char* bp = lds + bias_lane + 256 * dist;
                        f32x4 L[8];
#pragma unroll
                        for (int m = 0; m < 8; ++m) L[m] = *(const LAS f32x4*)(bp + 32 * m);
#pragma unroll
                        for (int r = 0; r < 16; ++r) { const int g = r >> 2, e = r & 3; p0[r] += L[7 - g][3 - e]; p1[r] += L[3 - g][3 - e]; } }
                }
                float mx = p0[0];
#pragma unroll
                for (int r = 0; r < 16; ++r) { mx = fmaxf(mx, p0[r]); mx = fmaxf(mx, p1[r]); }
                mx = fmaxf(mx, shx(mx, lane, 32));
                if (!started || __any(mx > 8.f)) {
                    const float delta = started ? fmaxf(mx, 0.f) : mx;
                    if (started) { const float alpha = ex2(-delta); l_run *= alpha; o[0] *= alpha; o[1] *= alpha; }
                    const float nm = negm[0] - delta;
#pragma unroll
                    for (int r = 0; r < 16; ++r) { negm[r] = nm; p0[r] -= delta; p1[r] -= delta; }
                    started = true;
                }
                float sum = 0.f;
#pragma unroll
                for (int r = 0; r < 16; ++r) { p0[r] = ex2(p0[r]); p1[r] = ex2(p1[r]); sum += p0[r] + p1[r]; }
                l_run += sum;
            }
            const bf16x8 pb0 = pack8(p0, 0), pb1 = pack8(p0, 1), pb2 = pack8(p1, 0), pb3 = pack8(p1, 1);
            LAS const unsigned char* Vb = lds + OFF_V + buf * 8192;
#pragma unroll
            for (int d0 = 0; d0 < 2; ++d0) {
                LAS const unsigned char* vp = Vb + (d0 ? vb1 : vb0);
                bf16x8 vf[4];
#pragma unroll
                for (int ks = 0; ks < 4; ++ks) {
                    const s16x4 lo = vtr(vp + (16 * ks) * 128), hi = vtr(vp + (16 * ks + 8) * 128);
                    vf[ks] = __builtin_shufflevector(lo, hi, 0, 1, 2, 3, 4, 5, 6, 7); }
                __builtin_amdgcn_sched_barrier(0);
#pragma unroll
                for (int ks = 0; ks < 4; ++ks) o[d0] = MFMA32(vf[ks], (ks == 0 ? pb0 : ks == 1 ? pb1 : ks == 2 ? pb2 : pb3), o[d0]);
            }
        }
        if (it + 1 < nsteps) ATT_WRITE(buf ^ 1);
        if (BG_CONV) bg.step(lane, lds);
        if (it + 2 < nsteps) ATT_ISSUE(TILE_OF(it + 2));
        asm volatile("s_waitcnt lgkmcnt(0)" ::: "memory");
        __builtin_amdgcn_s_barrier();
        asm volatile("" ::: "memory");
    }
    if (KIND == 1) { asm volatile("s_waitcnt lgkmcnt(0)" ::: "memory"); __builtin_amdgcn_s_barrier(); asm volatile("" ::: "memory"); }
    __builtin_amdgcn_s_setprio(0);
    if (nx.has) attn_prefetch<KIND>(tid, pre, nx, qpitch, k0pitch, k1src, vpitch);
    float inv = 1.f;
    if (KIND != 1) { const float lt = l_run + shx(l_run, lane, 32); inv = 1.f / lt; }
    LAS unsigned char* st = lds + (w < 4 ? 45056 + w * 4608 : 131072 + (w - 4) * 4608);
#pragma unroll
    for (int d0 = 0; d0 < 2; ++d0)
#pragma unroll
        for (int g = 0; g < 4; ++g) {
            u32x2 v; v.x = cvtpk(o[d0][4 * g] * inv, o[d0][4 * g + 1] * inv); v.y = cvtpk(o[d0][4 * g + 2] * inv, o[d0][4 * g + 3] * inv);
            *(LAS u32x2*)(st + r32 * 144 + (32 * d0 + 8 * g + 4 * hh) * 2) = v;
        }
    { bf16* ob = odst + (size_t)(rowbase + qblk * 256 + 32 * w + (lane >> 3)) * DM + 8 * (lane & 7);
      LAS const unsigned char* sr = st + (lane >> 3) * 144 + (lane & 7) * 16;
#pragma unroll
      for (int i = 0; i < 4; ++i) { const u32x4 t = *(LAS const u32x4*)(sr + i * 8 * 144); *(u32x4*)(ob + (size_t)i * 8 * DM) = t; } }
    if (mstat) { float ss = 0.f;
#pragma unroll
        for (int d0 = 0; d0 < 2; ++d0)
#pragma unroll
            for (int r = 0; r < 16; ++r) { const float t = o[d0][r] * inv; ss += t * t; }
        ss += shx(ss, lane, 32);
        if (hh == 0) mstat[(size_t)(rowbase + qblk * 256 + 32 * w + r32) * 16] = ss; }
#undef TILE_OF
#undef ATT_ISSUE
#undef ATT_ISSUE_X
#undef ATT_WRITE
}

struct MapIdent { __device__ __forceinline__ int row(int n) const { return n; } __device__ __forceinline__ float ns(int) const { return 1.f; } __device__ __forceinline__ float kg(int) const { return 1.f; } };
struct MapKG { const float* g; __device__ __forceinline__ int row(int n) const { return n; } __device__ __forceinline__ float ns(int) const { return 1.f; } __device__ __forceinline__ float kg(int k) const { return g[k]; } };
struct MapWin {
    __device__ __forceinline__ int row(int n) const { if (n < 384) return n; if (n < 416) { const int j = n - 384; return (j < 16) ? 384 + 2 * j : 384 + 2 * (j - 16) + 1; } return n + 96; }
    __device__ __forceinline__ float ns(int n) const { return ((n >= 416 && n < 672) || (n >= 1184 && n < 1440)) ? 0.125f * LOG2E : 1.f; }
    __device__ __forceinline__ float kg(int) const { return 1.f; }
};
struct MapWinG { const float* g;
    __device__ __forceinline__ int row(int n) const { return MapWin{}.row(n); }
    __device__ __forceinline__ float ns(int n) const { return MapWin{}.ns(n); }
    __device__ __forceinline__ float kg(int k) const { return g[k]; }
};
struct MapWuq { const float* g;
    __device__ __forceinline__ int row(int n) const { const int h = n / 96, d = n % 96; if (d < 64) return n; const int j = d - 64; return 96 * h + 64 + ((j < 16) ? 2 * j : 2 * (j - 16) + 1); }
    __device__ __forceinline__ float ns(int) const { return 0.10206207261596575f * LOG2E; }
    __device__ __forceinline__ float kg(int k) const { return g[k]; }
};
struct MapWgu {
    __device__ __forceinline__ int row(int n) const { if (n < 1024) return 256 * (n >> 7) + (n & 127); const int n2 = n - 1024; return 256 * (n2 >> 7) + 128 + (n2 & 127); }
    __device__ __forceinline__ float ns(int) const { return 1.f; } __device__ __forceinline__ float kg(int) const { return 1.f; }
};
template <class Map>
__device__ __forceinline__ void cvt_item(const float* __restrict__ W, const int K, const int N, bf16* __restrict__ WT, LAS float* scr, const int item, const int lane, const Map mp) {
    const int nblk = N / 32, kb = item / nblk, nb = item % nblk, k0 = 64 * kb, n0 = 32 * nb;
    float rr[32];
#pragma unroll
    for (int i = 0; i < 32; ++i) { const int kk = 2 * i + (lane >> 5); rr[i] = __builtin_nontemporal_load(W + (size_t)(k0 + kk) * N + n0 + (lane & 31)); }
#pragma unroll
    for (int i = 0; i < 32; ++i) { const int kk = 2 * i + (lane >> 5); scr[kk * 33 + (lane & 31)] = rr[i] * mp.kg(k0 + kk); }
    LDS_WAIT(); asm volatile("" ::: "memory");
    const int cc = lane & 7;
#pragma unroll
    for (int j = 0; j < 4; ++j) { const int n = (lane >> 3) + 8 * j; const LAS float* s = scr + (8 * cc) * 33 + n; const float sc = mp.ns(n0 + n);
        u32x4 o; o.x = cvtpk(s[0 * 33] * sc, s[1 * 33] * sc); o.y = cvtpk(s[2 * 33] * sc, s[3 * 33] * sc); o.z = cvtpk(s[4 * 33] * sc, s[5 * 33] * sc); o.w = cvtpk(s[6 * 33] * sc, s[7 * 33] * sc);
        *(u32x4*)(WT + (size_t)mp.row(n0 + n) * K + k0 + 8 * cc) = o; }
    LDS_WAIT(); asm volatile("" ::: "memory");
}

template <class Map>
__device__ __forceinline__ void cvt_item_fp8(const float* __restrict__ W, const int K, const int N, unsigned char* __restrict__ WT, LAS float* scr, const int item, const int lane, const Map mp, const float scale) {
    const int nblk = N / 32, kb = item / nblk, nb = item % nblk, k0 = 64 * kb, n0 = 32 * nb;
    float rr[32];
#pragma unroll
    for (int i = 0; i < 32; ++i) { const int kk = 2 * i + (lane >> 5); rr[i] = __builtin_nontemporal_load(W + (size_t)(k0 + kk) * N + n0 + (lane & 31)); }
#pragma unroll
    for (int i = 0; i < 32; ++i) { const int kk = 2 * i + (lane >> 5); scr[kk * 33 + (lane & 31)] = rr[i] * scale; }
    LDS_WAIT(); asm volatile("" ::: "memory");
    const int cc = lane & 7;
#pragma unroll
    for (int j = 0; j < 4; ++j) { const int n = (lane >> 3) + 8 * j; const LAS float* s = scr + (8 * cc) * 33 + n;
        const float sc = mp.ns(n0 + n);
        u32x2 o; o.x = pk4_fp8_sat(s[0 * 33] * sc, s[1 * 33] * sc, s[2 * 33] * sc, s[3 * 33] * sc); o.y = pk4_fp8_sat(s[4 * 33] * sc, s[5 * 33] * sc, s[6 * 33] * sc, s[7 * 33] * sc);
        *(u32x2*)(WT + (size_t)mp.row(n0 + n) * K + k0 + 8 * cc) = o; }
    LDS_WAIT(); asm volatile("" ::: "memory");
}

template <class Map>
__device__ __forceinline__ void cvt_item_fp8_k128(const float* __restrict__ W, const int K, const int N, unsigned char* __restrict__ WT, LAS float* scr, const int item, const int lane, const Map mp, const float scale) {
    const int nblk = N / 32, kb = item / nblk, nb = item % nblk, k0 = 128 * kb, n0 = 32 * nb;
#pragma unroll
    for (int hf = 0; hf < 2; ++hf) {
        float rr[32];
#pragma unroll
        for (int i = 0; i < 32; ++i) { const int kk = 64 * hf + 2 * i + (lane >> 5); rr[i] = __builtin_nontemporal_load(W + (size_t)(k0 + kk) * N + n0 + (lane & 31)); }
#pragma unroll
        for (int i = 0; i < 32; ++i) { const int kk = 64 * hf + 2 * i + (lane >> 5); scr[kk * 33 + (lane & 31)] = rr[i] * scale; }
    }
    LDS_WAIT(); asm volatile("" ::: "memory");
    const int cc = lane & 7;
#pragma unroll
    for (int j = 0; j < 4; ++j) { const int n = (lane >> 3) + 8 * j; const LAS float* s = scr + (16 * cc) * 33 + n; const float sc = mp.ns(n0 + n);
        u32x4 o;
        o.x = pk4_fp8_sat(s[0 * 33] * sc, s[1 * 33] * sc, s[2 * 33] * sc, s[3 * 33] * sc); o.y = pk4_fp8_sat(s[4 * 33] * sc, s[5 * 33] * sc, s[6 * 33] * sc, s[7 * 33] * sc);
        o.z = pk4_fp8_sat(s[8 * 33] * sc, s[9 * 33] * sc, s[10 * 33] * sc, s[11 * 33] * sc); o.w = pk4_fp8_sat(s[12 * 33] * sc, s[13 * 33] * sc, s[14 * 33] * sc, s[15 * 33] * sc);
        *(u32x4*)(WT + (size_t)mp.row(n0 + n) * K + k0 + 16 * cc) = o; }
    LDS_WAIT(); asm volatile("" ::: "memory");
}

__device__ __forceinline__ void norm_store_bf16(const f32x4 (&v)[4], const float rstd, const float* __restrict__ g, bf16* __restrict__ orow, const int lane) {
#pragma unroll
    for (int j = 0; j < 2; ++j) { const f32x4 g0 = *(const f32x4*)(g + 8 * lane + 512 * j), g1 = *(const f32x4*)(g + 8 * lane + 512 * j + 4);
        const f32x4 a = v[2 * j] * rstd * g0, b = v[2 * j + 1] * rstd * g1;
        u32x4 w; w.x = cvtpk(a[0], a[1]); w.y = cvtpk(a[2], a[3]); w.z = cvtpk(b[0], b[1]); w.w = cvtpk(b[2], b[3]);
        *(u32x4*)(orow + 8 * lane + 512 * j) = w; }
}
__device__ __forceinline__ void norm_store_fp8(const f32x4 (&v)[4], const float rstd, const float* __restrict__ g, unsigned char* __restrict__ orow, const int lane, const float sc) {
#pragma unroll
    for (int j = 0; j < 2; ++j) { const f32x4 g0 = *(const f32x4*)(g + 8 * lane + 512 * j), g1 = *(const f32x4*)(g + 8 * lane + 512 * j + 4);
        const f32x4 a = v[2 * j] * (rstd * sc) * g0, b = v[2 * j + 1] * (rstd * sc) * g1;
        *(u32x2*)(orow + 8 * lane + 512 * j) = (u32x2){pk4_fp8(a[0], a[1], a[2], a[3]), pk4_fp8(b[0], b[1], b[2], b[3])}; }
}
__device__ __forceinline__ float sumsq4(const f32x4 (&v)[4]) {
    float s = 0.f;
#pragma unroll
    for (int j = 0; j < 4; ++j) s += (v[j][0] * v[j][0] + v[j][1] * v[j][1]) + (v[j][2] * v[j][2] + v[j][3] * v[j][3]);
    return s;
}

struct Args { const float* in[19]; float* out; unsigned char* ws; };


typedef const __attribute__((address_space(4))) struct Args* CArgsP;
#define PH_BEGIN CArgsP ap_; { unsigned long long kp_ = (unsigned long long)__builtin_amdgcn_kernarg_segment_ptr(); asm volatile("" : "+s"(kp_)); ap_ = (CArgsP)kp_; } unsigned char* const ws = ap_->ws; \
    int w_ = bar.w, bx_ = (int)blockIdx.x; asm volatile("" : "+s"(w_), "+s"(bx_)); int tid_ = (w_ << 6) | lane_id(); asm volatile("" : "+v"(tid_)); \
    const int tid = tid_, bx = bx_, lane = tid & 63, wave = __builtin_amdgcn_readfirstlane(tid >> 6), G = (int)gridDim.x; \
    const int vcu = (G % 8 == 0) ? (bx % 8) * (G / 8) + bx / 8 : bx; const int gw = vcu * NWAVES + wave, NGW = G * NWAVES; (void)lane; (void)gw; (void)NGW
#define ctl ((unsigned*)(ws + WS_CTL))
#define x_in (ap_->in[0])
#define positions ((const int*)ap_->in[1])
#define attn_norm (ap_->in[2])
#define w_in (ap_->in[3])
#define q_norm (ap_->in[4])
#define w_uq (ap_->in[5])
#define kv_norm (ap_->in[6])
#define w_ukv (ap_->in[7])
#define rel_bias (ap_->in[8])
#define mix_norm (ap_->in[9])
#define w_o (ap_->in[10])
#define ffn_norm (ap_->in[11])
#define w_router (ap_->in[12])
#define b_router (ap_->in[13])
#define w_gu (ap_->in[14])
#define b_gu (ap_->in[15])
#define w_dn (ap_->in[16])
#define b_dn (ap_->in[17])
#define final_norm (ap_->in[18])
#define Rres (ap_->out)
#define R16 ((bf16*)(ws + WS_R16))
#define MSTAT ((float*)(ws + WS_MSTAT))
#define WinT ((bf16*)(ws + WS_WIN))
#define WuqT ((bf16*)(ws + WS_WUQ))
#define WukvT ((bf16*)(ws + WS_WUKV))
#define WoT ((bf16*)(ws + WS_WO))
#define WguT ((unsigned char*)(ws + WS_WGU))
#define WdnT ((unsigned char*)(ws + WS_WDN))
#define H8 ((unsigned char*)(ws + WS_H8))
#define ropecs ((f32x2*)(ws + WS_ROPE))
#define rstd ((float*)(ws + WS_RSTD))
#define kpe_r ((bf16*)(ws + WS_KPE))
#define tok_of ((int*)(ws + WS_TOK))
#define gate_of ((float*)(ws + WS_GATE))
#define Hb ((bf16*)(ws + WS_H))
#define PROJ ((bf16*)(ws + WS_PROJ))
#define QB ((bf16*)(ws + WS_QB))
#define KVB ((bf16*)(ws + WS_KVB))
#define MIXED ((bf16*)(ws + WS_MIXED))
#define ACT ((unsigned char*)(ws + WS_ACT))
#define YS ((bf16*)(ws + WS_YS))
#ifndef REP_MASK
#define REP_MASK 0
#endif
#define NREP(k) (((REP_MASK >> (k)) & 1) ? 2 : 1)
#define IN(k) (((KMASK >> (k)) & 1) != 0)
#define SEAM(k) do { if (MULTI) xcd_barrier(bar); } while (0)
template <int KMASK, int l>
__device__ __forceinline__ void layer_body(LAS unsigned char* lds, const XcdBarrier& bar) {
    constexpr bool MULTI = (KMASK & (KMASK - 1)) != 0;
        constexpr int pb = 0;
        if (IN(pb + 0)) for (int rep_ = 0; rep_ < NREP(0); ++rep_) {
            PH_BEGIN;
            pg8::DenseSched S; S.init(NTOK, NPROJ, G, bx, DG_FP8 ? DM : DM * 2, 0);
            pg8::EpiStore E{PROJ, NPROJ, nullptr, 0, DG_FP8 ? 1.f / (H_SCALE * W_SCALE) : 1.f};
            if (DG_FP8) pg8::gemm_phase<pg8::EpiStore, pg8::DenseSched, true>(tid, lds, H8, (unsigned char*)WinT + (size_t)l * NPROJ * 1024, 1024, S, E);
            else if (PREP_FUSED) { pg8::EpiProj EP{ws, 1.f}; pg8::gemm_phase(tid, lds, NORM_FOLD ? R16 : Hb, WinT + (size_t)l * NPROJ * 1024, 2048, S, EP); }
            else pg8::gemm_phase(tid, lds, Hb, WinT + (size_t)l * NPROJ * 1024, 2048, S, E);
        }
        SEAM(pb + 0);
        if (IN(pb + 1) && !PREP_FUSED) for (int rep_ = 0; rep_ < NREP(1); ++rep_) {
            PH_BEGIN;
            for (int row = gw; row < NTOK; row += NGW) {
                const bf16* pr = PROJ + (size_t)row * NPROJ;
                u32x4 v = (u32x4){0u, 0u, 0u, 0u};
                if (lane < 52) v = *(const u32x4*)(pr + 8 * lane);
                float e[8]; e[0] = bf_lo(v.x); e[1] = bf_hi(v.x); e[2] = bf_lo(v.y); e[3] = bf_hi(v.y); e[4] = bf_lo(v.z); e[5] = bf_hi(v.z); e[6] = bf_lo(v.w); e[7] = bf_hi(v.w);
                float ss = 0.f;
#pragma unroll
                for (int j = 0; j < 8; ++j) ss += e[j] * e[j];
                const float sq = wave_sum(lane < 32 ? ss : 0.f, lane), skv = wave_sum((lane >= 32 && lane < 48) ? ss : 0.f, lane);
                if (lane == 0) { rstd[row * 2 + 0] = rsqrtf(sq * (1.f / 256.f) + RMS_EPS); rstd[row * 2 + 1] = rsqrtf(skv * (1.f / 128.f) + RMS_EPS); }
                if (lane >= 48 && lane < 52) { const int i0 = 4 * (lane - 48); const f32x2* cs = ropecs + (size_t)row * 16 + i0; u32x4 w;
                    { const f32x2 c0 = cs[0]; w.x = cvtpk(e[0] * c0.x - e[1] * c0.y, e[1] * c0.x + e[0] * c0.y); }
                    { const f32x2 c0 = cs[1]; w.y = cvtpk(e[2] * c0.x - e[3] * c0.y, e[3] * c0.x + e[2] * c0.y); }
                    { const f32x2 c0 = cs[2]; w.z = cvtpk(e[4] * c0.x - e[5] * c0.y, e[5] * c0.x + e[4] * c0.y); }
                    { const f32x2 c0 = cs[3]; w.w = cvtpk(e[6] * c0.x - e[7] * c0.y, e[7] * c0.x + e[6] * c0.y); }
                    *(u32x4*)(kpe_r + (size_t)row * 32 + 8 * (lane - 48)) = w; }
            }
        }
        if (!PREP_FUSED) SEAM(pb + 1);
        if (IN(pb + 2)) for (int rep_ = 0; rep_ < NREP(2); ++rep_) {
            PH_BEGIN;
            { pg8::DenseSched S; S.init(NTOK, 768, G, bx, NPROJ * 2, PC_CQ * 2);
              pg8::EpiQ E{QB, rstd, ropecs};
              int kq = 512; asm volatile("" : "+s"(kq));
              pg8::gemm_phase(tid, lds, PROJ, WuqT + (size_t)l * 768 * 256, kq, S, E); }
            { pg8::DenseSched S; S.init(NTOK, 1024, G, bx, NPROJ * 2, PC_CKV * 2);
              pg8::EpiStore E{KVB, 1024, rstd, 1, 1.f};
              int kk = 256; asm volatile("" : "+s"(kk));
              pg8::gemm_phase(tid, lds, PROJ, WukvT + (size_t)l * 1024 * 128, kk, S, E); }
        }
        SEAM(pb + 2);
        if (IN(pb + 3)) for (int rep_ = 0; rep_ < NREP(3); ++rep_) {
            PH_BEGIN;
            BgConv bg; bg.wgu = w_gu + (size_t)l * NEXP * 1024 * 2048; bg.wdn = w_dn + (size_t)l * NEXP * 1024 * 1024; bg.gu8 = WguT + (size_t)l * NEXP * 2048 * 1024; bg.dn8 = WdnT + (size_t)l * NEXP * 1024 * 1024;
            bg.lds_scr = 65536u + (unsigned)wave * 8192u; bg.next = gw; bg.stride = NGW; bg.total = BG_CONV ? (BgConv::NGU + BgConv::NDN) : 0; bg.pend = -1; bg.tick = 0;
#define ATT_CC(itx) int cc = (itx) & 255; cc = (cc % 8) * 32 + cc / 8
#define MLA_UNIT(itx_, b_, h_, qb_) const int r_##b_ = (itx_) >> 8; int c_##b_ = (itx_) & 255; c_##b_ = (c_##b_ % 8) * 32 + c_##b_ / 8; const int b_ = c_##b_ >> 4, h_ = (c_##b_ >> 1) & 7; \
                const int qb_ = (c_##b_ & 1) ? ((r_##b_ == 0) ? 1 : (r_##b_ == 1) ? 6 : (r_##b_ == 2) ? 3 : 4) : ((r_##b_ == 0) ? 0 : (r_##b_ == 1) ? 7 : (r_##b_ == 2) ? 2 : 5)
            for (int rk_ = 0; rk_ < NREP(11); ++rk_) { int t0 = (wave << 6) | lane_id(); asm volatile("" : "+v"(t0)); AttnPre<6> pre0; pre0.valid = true;
              { MLA_UNIT(bx, bp, hp, qbp); AttnNext n0; n0.has = true; n0.qsrc = QB + 96 * hp; n0.k0src = KVB + 128 * hp; n0.vsrc = KVB + 128 * hp + 64; n0.rowbase = bp * SEQ; n0.qblk = qbp; attn_prefetch<0>(t0, pre0, n0, 768, 1024, kpe_r, 1024); }
              for (int itx = bx; itx < 1024; itx += G) { MLA_UNIT(itx, b, h, qb); MLA_UNIT(itx + G, bn, hn, qbn);
                AttnNext nx; nx.has = (itx + G) < 1024; nx.qsrc = QB + 96 * hn; nx.k0src = KVB + 128 * hn; nx.vsrc = KVB + 128 * hn + 64; nx.rowbase = bn * SEQ; nx.qblk = qbn;
                attn_unit<0>(t0, lds, QB + 96 * h, 768, KVB + 128 * h, 1024, kpe_r, KVB + 128 * h + 64, 1024, MIXED + 64 * h, nullptr, b * SEQ, qb, MIX_FUSED ? MSTAT + (size_t)l * NTOK * 16 + h : nullptr, bg, pre0, nx); } }
#undef MLA_UNIT
#define SB_UNIT(itx_, b_, h_, qb_) const int r_##b_ = (itx_) >> 8; int c_##b_ = (itx_) & 255; c_##b_ = (c_##b_ % 8) * 32 + c_##b_ / 8; const int b_ = c_##b_ >> 4, h_ = (c_##b_ >> 2) & 3; \
                const int qb_ = (r_##b_ == 4) ? (c_##b_ & 3) : 7 - (c_##b_ & 3)
            for (int rk_ = 0; rk_ < NREP(12); ++rk_) { int t1 = (wave << 6) | lane_id(); asm volatile("" : "+v"(t1)); AttnPre<4> pre1; pre1.valid = true;
              { SB_UNIT(1024 + bx, bp, hp, qbp); AttnNext n0; n0.has = true; n0.qsrc = PROJ + PC_SBQ + 64 * hp; n0.k0src = PROJ + PC_SBK + 64 * hp; n0.vsrc = PROJ + PC_SBV + 64 * hp; n0.rowbase = bp * SEQ; n0.qblk = qbp; attn_prefetch<1>(t1, pre1, n0, NPROJ, NPROJ, nullptr, NPROJ); }
              for (int itx = 1024 + bx; itx < 1536; itx += G) { SB_UNIT(itx, b, h, qb); SB_UNIT(itx + G, bn, hn, qbn);
                AttnNext nx; nx.has = (itx + G) < 1536; nx.qsrc = PROJ + PC_SBQ + 64 * hn; nx.k0src = PROJ + PC_SBK + 64 * hn; nx.vsrc = PROJ + PC_SBV + 64 * hn; nx.rowbase = bn * SEQ; nx.qblk = qbn;
                attn_unit<1>(t1, lds, PROJ + PC_SBQ + 64 * h, NPROJ, PROJ + PC_SBK + 64 * h, NPROJ, nullptr, PROJ + PC_SBV + 64 * h, NPROJ, MIXED + 512 + 64 * h, nullptr, b * SEQ, qb, MIX_FUSED ? MSTAT + (size_t)l * NTOK * 16 + 8 + h : nullptr, bg, pre1, nx); } }
#undef SB_UNIT
#define CA_UNIT(itx_, b_, h_, qb_) const int r_##b_ = (itx_) >> 8; int c_##b_ = (itx_) & 255; c_##b_ = (c_##b_ % 8) * 32 + c_##b_ / 8; const int b_ = c_##b_ >> 4, h_ = (c_##b_ >> 2) & 3; \
                const int qb_ = 2 * (c_##b_ & 3) + (r_##b_ - 6)
            for (int rk_ = 0; rk_ < NREP(13); ++rk_) { int t2 = (wave << 6) | lane_id(); asm volatile("" : "+v"(t2)); AttnPre<4> pre2; pre2.valid = true;
              { CA_UNIT(1536 + bx, bp, hp, qbp); AttnNext n0; n0.has = true; n0.qsrc = PROJ + PC_CAQ + 64 * hp; n0.k0src = PROJ + PC_CAK + 64 * hp; n0.vsrc = PROJ + PC_CAV + 64 * hp; n0.rowbase = bp * SEQ; n0.qblk = qbp; attn_prefetch<2>(t2, pre2, n0, NPROJ, NPROJ, nullptr, NPROJ); }
              for (int itx = 1536 + bx; itx < 2048; itx += G) { CA_UNIT(itx, b, h, qb); CA_UNIT(itx + G, bn, hn, qbn);
                AttnNext nx; nx.has = (itx + G) < 2048; nx.qsrc = PROJ + PC_CAQ + 64 * hn; nx.k0src = PROJ + PC_CAK + 64 * hn; nx.vsrc = PROJ + PC_CAV + 64 * hn; nx.rowbase = bn * SEQ; nx.qblk = qbn;
                attn_unit<2>(t2, lds, PROJ + PC_CAQ + 64 * h, NPROJ, PROJ + PC_CAK + 64 * h, NPROJ, nullptr, PROJ + PC_CAV + 64 * h, NPROJ, MIXED + 768 + 64 * h, rel_bias + ((size_t)l * 4 + h) * 513, b * SEQ, qb, MIX_FUSED ? MSTAT + (size_t)l * NTOK * 16 + 12 + h : nullptr, bg, pre2, nx); } }
#undef CA_UNIT
#undef ATT_CC
            if (BG_CONV) bg.flush(lane_id(), lds);
        }
        SEAM(pb + 3);
        if (IN(pb + 4) && !MIX_FUSED) for (int rep_ = 0; rep_ < NREP(4); ++rep_) {
            PH_BEGIN;
            const float* g = mix_norm + (size_t)l * DM;
            for (int row = gw; row < NTOK; row += NGW) {
                bf16* mr = MIXED + (size_t)row * DM + 16 * lane;
                const u32x4 a = *(const u32x4*)mr, b = *(const u32x4*)(mr + 8);
                float e[16]; e[0] = bf_lo(a.x); e[1] = bf_hi(a.x); e[2] = bf_lo(a.y); e[3] = bf_hi(a.y); e[4] = bf_lo(a.z); e[5] = bf_hi(a.z); e[6] = bf_lo(a.w); e[7] = bf_hi(a.w);
                e[8] = bf_lo(b.x); e[9] = bf_hi(b.x); e[10] = bf_lo(b.y); e[11] = bf_hi(b.y); e[12] = bf_lo(b.z); e[13] = bf_hi(b.z); e[14] = bf_lo(b.w); e[15] = bf_hi(b.w);
                float ss = 0.f;
#pragma unroll
                for (int j = 0; j < 16; ++j) ss += e[j] * e[j];
                const float sa = wave_sum(lane < 32 ? ss : 0.f, lane), sb = wave_sum((lane >= 32 && lane < 48) ? ss : 0.f, lane), sc = wave_sum(lane >= 48 ? ss : 0.f, lane);
                const float rs = (lane < 32) ? rsqrtf(sa * (1.f / 512.f) + RMS_EPS) : (lane < 48) ? rsqrtf(sb * (1.f / 256.f) + RMS_EPS) : rsqrtf(sc * (1.f / 256.f) + RMS_EPS);
                const float* gp = g + 16 * lane; unsigned w[8];
#pragma unroll
                for (int j = 0; j < 8; ++j) w[j] = cvtpk(e[2 * j] * rs * gp[2 * j], e[2 * j + 1] * rs * gp[2 * j + 1]);
                if (DG_FP8) { unsigned q[4];
#pragma unroll
                    for (int j = 0; j < 4; ++j) q[j] = pk4_fp8(e[4 * j] * rs * gp[4 * j] * H_SCALE, e[4 * j + 1] * rs * gp[4 * j + 1] * H_SCALE, e[4 * j + 2] * rs * gp[4 * j + 2] * H_SCALE, e[4 * j + 3] * rs * gp[4 * j + 3] * H_SCALE);
                    *(u32x4*)(H8 + (size_t)row * DM + 16 * lane) = (u32x4){q[0], q[1], q[2], q[3]}; }
                else { *(u32x4*)mr = (u32x4){w[0], w[1], w[2], w[3]}; *(u32x4*)(mr + 8) = (u32x4){w[4], w[5], w[6], w[7]}; }
            }
        }
        if (!MIX_FUSED) SEAM(pb + 4);
        if (IN(pb + 5)) for (int rep_ = 0; rep_ < NREP(5); ++rep_) {
            PH_BEGIN;
            pg8::DenseSched S; S.init(NTOK, DM, G, bx, DG_FP8 ? DM : DM * 2, 0);
            pg8::EpiResid E{(l == 0) ? x_in : (const float*)nullptr, R16, DG_FP8 ? 1.f / (H_SCALE * W_SCALE) : 1.f};
            if (DG_FP8) pg8::gemm_phase<pg8::EpiResid, pg8::DenseSched, true>(tid, lds, H8, (unsigned char*)WoT + (size_t)l * 1024 * 1024, 1024, S, E);
            else if (MIX_FUSED) { pg8::EpiResidNorm EN{(l == 0 && !NORM_FOLD) ? x_in : (const float*)nullptr, R16, MSTAT + (size_t)l * NTOK * 16};
                pg8::gemm_phase(tid, lds, MIXED, WoT + (size_t)l * 1024 * 1024, 2048, S, EN); }
            else pg8::gemm_phase(tid, lds, MIXED, WoT + (size_t)l * 1024 * 1024, 2048, S, E);
        }
        SEAM(pb + 5);
        if (IN(pb + 6)) for (int rep_ = 0; rep_ < NREP(6); ++rep_) {
            PH_BEGIN;
            LAS int* lcnt = (LAS int*)(lds + LDS_MISC); LAS int* lbase = (LAS int*)(lds + LDS_MISC + 128);
            constexpr int NENT = 1024;
            LAS int* ent_e = (LAS int*)(lds + LDS_MISC + 512); LAS float* ent_g = (LAS float*)(lds + LDS_MISC + 512 + 4 * NENT); LAS int* ent_s = (LAS int*)(lds + LDS_MISC + 512 + 8 * NENT);
            const float* fg = ffn_norm + (size_t)l * DM;
            { const u32x4* wsrc = (const u32x4*)(ws + WS_WRT + (size_t)l * 131072);
              for (int i = tid; i < 8192; i += 512) *(LAS u32x4*)(lds + i * 16) = wsrc[i]; }
            if (tid < 32) lcnt[tid] = 0;
            for (int i = tid; i < NENT; i += 512) ent_e[i] = -1;
            __syncthreads();
            const int t16 = lane & 15, q = lane >> 4;
            float bias[8];
#pragma unroll
            for (int j = 0; j < 8; ++j) bias[j] = b_router[l * NEXP + 16 * (j >> 2) + 4 * q + (j & 3)];
            f32x4 g4[4];
#pragma unroll
            for (int j = 0; j < 4; ++j) g4[j] = *(const f32x4*)(fg + 4 * lane + 256 * j);
            int itn = 0;
            for (int grp = gw; grp < NTOK / 16; grp += NGW, ++itn) {
                const int row0 = grp * 16;
                const bf16* xp = R16 + (size_t)(row0 + t16) * DM + 8 * q;
                LAS const unsigned char* wl = lds + lane * 16;
                f32x4 a00 = (f32x4){0.f, 0.f, 0.f, 0.f}, a01 = a00, a10 = a00, a11 = a00, ss = a00;
#pragma unroll
                for (int s = 0; s < 32; ++s) {
                    const bf16x8 xf = *(const bf16x8*)(xp + 32 * s);
                    const bf16x8 w00 = *(const LAS bf16x8*)(wl + (s * 4 + 0) * 1024), w01 = *(const LAS bf16x8*)(wl + (s * 4 + 1) * 1024);
                    const bf16x8 w10 = *(const LAS bf16x8*)(wl + (s * 4 + 2) * 1024), w11 = *(const LAS bf16x8*)(wl + (s * 4 + 3) * 1024);
                    a00 = MFMA16(w00, xf, a00); a01 = MFMA16(w01, xf, a01); a10 = MFMA16(w10, xf, a10); a11 = MFMA16(w11, xf, a11);
                    ss = MFMA16(xf, xf, ss);
                }
                const int sel = t16 & 3;
                const float mine = (sel == 0) ? ss[0] : (sel == 1) ? ss[1] : (sel == 2) ? ss[2] : ss[3];
                const float ssq = __builtin_bit_cast(float, __builtin_amdgcn_ds_bpermute((t16 + 16 * (t16 >> 2)) << 2, __builtin_bit_cast(int, mine)));
                const float rs = rsqrtf(ssq * (1.f / DM) + RMS_EPS);
                float lg[8]; int key[8];
#pragma unroll
                for (int j = 0; j < 8; ++j) { const float d = (j < 4) ? (a00[j & 3] + a01[j & 3]) : (a10[j & 3] + a11[j & 3]); lg[j] = d * rs + bias[j];
                    const int e = 16 * (j >> 2) + 4 * q + (j & 3); const int bb = __builtin_bit_cast(int, lg[j]); const int kk = (bb >= 0) ? bb : (bb ^ 0x7fffffff); key[j] = (kk & ~31) | (31 - e); }
                int es[4]; float vs[4];
#pragma unroll
                for (int k = 0; k < 4; ++k) {
                    int mx = key[0];
#pragma unroll
                    for (int j = 1; j < 8; ++j) mx = key[j] > mx ? key[j] : mx;
                    { const int tt = shxi(mx, lane, 16); mx = tt > mx ? tt : mx; }
                    { const int tt = shxi(mx, lane, 32); mx = tt > mx ? tt : mx; }
                    float vl = -INFINITY;
#pragma unroll
                    for (int j = 0; j < 8; ++j) { const bool hit = (key[j] == mx); vl = hit ? lg[j] : vl; key[j] = hit ? (int)0x80000000 : key[j]; }
                    vl = fmaxf(vl, shx(vl, lane, 16)); vl = fmaxf(vl, shx(vl, lane, 32));
                    es[k] = 31 - (mx & 31); vs[k] = vl;
                }
                const float e1 = __expf(vs[1] - vs[0]), e2 = __expf(vs[2] - vs[0]), e3 = __expf(vs[3] - vs[0]); const float rden = 1.f / (1.f + e1 + e2 + e3);
                { const int e = (q == 0) ? es[0] : (q == 1) ? es[1] : (q == 2) ? es[2] : es[3];
                  const float gt = ((q == 0) ? 1.f : (q == 1) ? e1 : (q == 2) ? e2 : e3) * rden;
                  const int pl = atomicAdd((int*)(lcnt + e), 1);
                  const int ei = (itn * NWAVES + wave) * 64 + t16 * 4 + q;
                  if (ei < NENT) { ent_e[ei] = e | (pl << 8); ent_g[ei] = gt; ent_s[ei] = (row0 + t16) * 4 + q; } }
#pragma unroll
                for (int r0 = 0; r0 < 16; r0 += 4) {
                    u32x2 y[4][4];
#pragma unroll
                    for (int t = 0; t < 4; ++t)
#pragma unroll
                        for (int j = 0; j < 4; ++j) y[t][j] = *(const u32x2*)(R16 + (size_t)(row0 + r0 + t) * DM + 4 * lane + 256 * j);
#pragma unroll
                    for (int t = 0; t < 4; ++t) { const float rsr = __builtin_bit_cast(float, __builtin_amdgcn_readlane(__builtin_bit_cast(int, rs), r0 + t)); const size_t row = (size_t)(row0 + r0 + t);
#pragma unroll
                        for (int j = 0; j < 4; ++j) { const f32x4 v = (f32x4){bf_lo(y[t][j].x), bf_hi(y[t][j].x), bf_lo(y[t][j].y), bf_hi(y[t][j].y)}; const f32x4 a = v * rsr * g4[j];
                            if (GU_FP8) *(unsigned*)(H8 + row * DM + 4 * lane + 256 * j) = pk4_fp8_scaled(a[0], a[1], a[2], a[3], 1.f / H_SCALE);
                            else *(u32x2*)(Hb + row * DM + 4 * lane + 256 * j) = (u32x2){cvtpk(a[0], a[1]), cvtpk(a[2], a[3])}; } }
                }
            }
            __syncthreads();
            if (tid < 32) lbase[tid] = (int)atomicAdd(ctl + CW_CNT + l * NEXP + tid, (unsigned)lcnt[tid]);
            __syncthreads();
            for (int i = tid; i < NENT; i += 512) { const int ee = ent_e[i]; if (ee >= 0) { const int e = ee & 255, pl = ee >> 8; const size_t idx = (size_t)e * NTOK + lbase[e] + pl; tok_of[idx] = ent_s[i]; gate_of[idx] = ent_g[i]; } }
        }
        SEAM(pb + 6);
#define MOE_TABLES() LAS int* pst = (LAS int*)(lds + LDS_MISC); LAS int* cn = (LAS int*)(lds + LDS_MISC + 256); \
            __syncthreads(); \
            if (tid < 64) { const int e_ = tid & 31; const int c_ = (int)__hip_atomic_load(ctl + CW_CNT + l * NEXP + e_, __ATOMIC_RELAXED, __HIP_MEMORY_SCOPE_AGENT); const int r_ = c_ & 255; \
                const int a_ = (c_ >> 8) + (r_ > 128 ? 1 : 0), b_ = (r_ >= 1 && r_ <= 128) ? 1 : 0; int sa_ = a_, sb_ = b_;        \
                _Pragma("unroll") for (int o_ = 1; o_ < 32; o_ <<= 1) { const int ta_ = __builtin_amdgcn_ds_bpermute(((tid - o_) & 63) << 2, sa_), tb_ = __builtin_amdgcn_ds_bpermute(((tid - o_) & 63) << 2, sb_); if (e_ >= o_) { sa_ += ta_; sb_ += tb_; } } \
                if (tid < 32) { cn[e_] = c_; pst[e_] = sa_ - a_; pst[128 + e_] = sb_ - b_; if (e_ == 31) { pst[NEXP] = sa_; pst[128 + NEXP] = sb_; } } } \
            __syncthreads(); \
            const int P = pst[NEXP] + pst[128 + NEXP]
        if (IN(pb + 7)) for (int rep_ = 0; rep_ < NREP(7); ++rep_) {
            PH_BEGIN;
            MOE_TABLES();
            pg8::MoeSched<0> S; S.pitchB = GU_FP8 ? 1024 : 2048; S.colB = 0; S.pst = pst; S.cn = cn; S.slots = lds + GEMM_SLOT0; S.NT = 8; S.G = G; S.c = bx; S.P = P; S.nunits = P * 8;
            S.tok = tok_of; S.gate = gate_of; S.bias = b_gu + (size_t)l * NEXP * 2048;
            pg8::EpiSwiglu E{ACT, 8, GU_FP8 ? 1.f / (H_SCALE * W_SCALE) : 1.f, DN_FP8 ? ACT_SCALE : 1.f};
            if (GU_FP8) pg8::gemm_phase<pg8::EpiSwiglu, pg8::MoeSched<0>, true>(tid, lds, H8, WguT + (size_t)l * NEXP * 2048 * 1024, 1024, S, E);
            else pg8::gemm_phase<pg8::EpiSwiglu, pg8::MoeSched<0>, false>(tid, lds, Hb, (bf16*)WguT + (size_t)l * NEXP * 2048 * 1024, 2048, S, E);
        }
        SEAM(pb + 7);
        if (IN(pb + 8)) for (int rep_ = 0; rep_ < NREP(8); ++rep_) {
            PH_BEGIN;
            MOE_TABLES();
            pg8::MoeSched<1> S; S.pitchB = DN_FP8 ? 1024 : 2048; S.colB = 0; S.pst = pst; S.cn = cn; S.slots = lds + GEMM_SLOT0; S.NT = 4; S.G = G; S.c = bx; S.P = P; S.nunits = P * 4;
            S.tok = tok_of; S.gate = gate_of; S.bias = b_dn + (size_t)l * NEXP * 1024;
            pg8::EpiDown E{YS, 4, DN_FP8 ? 1.f / (ACT_SCALE * W_SCALE) : 1.f};
            if (DN_FP8) pg8::gemm_phase<pg8::EpiDown, pg8::MoeSched<1>, true>(tid, lds, ACT, WdnT + (size_t)l * NEXP * 1024 * 1024, 1024, S, E);
            else pg8::gemm_phase<pg8::EpiDown, pg8::MoeSched<1>, false>(tid, lds, ACT, (bf16*)WdnT + (size_t)l * NEXP * 1024 * 1024, 2048, S, E);
        }
#undef MOE_TABLES
        SEAM(pb + 8);
        if (IN(pb + 9)) for (int rep_ = 0; rep_ < NREP(9); ++rep_) {
            PH_BEGIN;
            const bool lastl = (l == DEPTH - 1);
            const float* g = lastl ? final_norm : attn_norm + (size_t)(l + 1) * DM;
            for (int row0 = gw; row0 < NTOK; row0 += 2 * NGW) {
                f32x4 v[2][4]; u32x4 xin[2][2]; u32x2 y8[2][4][2];
#pragma unroll
                for (int t = 0; t < 2; ++t) { const int row = (row0 + t * NGW < NTOK) ? row0 + t * NGW : row0; const bf16* x16 = R16 + (size_t)row * DM;
#pragma unroll
                    for (int j = 0; j < 2; ++j) xin[t][j] = *(const u32x4*)(x16 + 8 * lane + 512 * j);
#pragma unroll
                    for (int k = 0; k < 4; ++k) { const unsigned char* yr8 = (const unsigned char*)YS + ((size_t)row * 4 + k) * DM;
#pragma unroll
                        for (int j = 0; j < 2; ++j) y8[t][k][j] = *(const u32x2*)(yr8 + 8 * lane + 512 * j); } }
#pragma unroll
                for (int t = 0; t < 2; ++t) { const int row = row0 + t * NGW; bf16* x16 = R16 + (size_t)row * DM; float* xr = Rres + (size_t)row * DM;
#pragma unroll
                    for (int j = 0; j < 2; ++j) { const u32x4 y = xin[t][j];
                        v[t][2 * j] = (f32x4){bf_lo(y.x), bf_hi(y.x), bf_lo(y.y), bf_hi(y.y)}; v[t][2 * j + 1] = (f32x4){bf_lo(y.z), bf_hi(y.z), bf_lo(y.w), bf_hi(y.w)}; }
#pragma unroll
                    for (int k = 0; k < 4; ++k)
#pragma unroll
                        for (int j = 0; j < 2; ++j) { const u32x2 y = y8[t][k][j];
                            const f32x2 a = __builtin_amdgcn_cvt_pk_f32_fp8((int)y.x, false), b = __builtin_amdgcn_cvt_pk_f32_fp8((int)y.x, true), c = __builtin_amdgcn_cvt_pk_f32_fp8((int)y.y, false), d = __builtin_amdgcn_cvt_pk_f32_fp8((int)y.y, true);
                            v[t][2 * j] += (f32x4){a.x, a.y, b.x, b.y} * (1.f / YS_SCALE); v[t][2 * j + 1] += (f32x4){c.x, c.y, d.x, d.y} * (1.f / YS_SCALE); }
                    const float rs = rsqrtf(wave_sum(sumsq4(v[t]), lane) * (1.f / DM) + RMS_EPS);
                    if (row < NTOK) {
                        if (lastl) {
#pragma unroll
                            for (int j = 0; j < 2; ++j) { const f32x4 g0 = *(const f32x4*)(g + 8 * lane + 512 * j), g1 = *(const f32x4*)(g + 8 * lane + 512 * j + 4);
                                *(f32x4*)(xr + 8 * lane + 512 * j) = v[t][2 * j] * rs * g0; *(f32x4*)(xr + 8 * lane + 512 * j + 4) = v[t][2 * j + 1] * rs * g1; }
                        } else {
#pragma unroll
                            for (int j = 0; j < 2; ++j) *(u32x4*)(x16 + 8 * lane + 512 * j) = (u32x4){cvtpk(v[t][2 * j][0], v[t][2 * j][1]), cvtpk(v[t][2 * j][2], v[t][2 * j][3]), cvtpk(v[t][2 * j + 1][0], v[t][2 * j + 1][1]), cvtpk(v[t][2 * j + 1][2], v[t][2 * j + 1][3])};
                            if (DG_FP8) norm_store_fp8(v[t], rs, g, H8 + (size_t)row * DM, lane, H_SCALE); else if (NORM_FOLD) { if (lane == 0) ((float*)(ws + WS_RSIN))[row] = rs; } else norm_store_bf16(v[t], rs, g, Hb + (size_t)row * DM, lane);
                        }
                    }
                }
            }
        }
        SEAM(pb + 9);
    }
#undef IN
#undef SEAM

template <int KMASK, int L0, int L1>
__global__ void __launch_bounds__(NWAVES * 64, 2) mk_fwd(Args args) {
    extern __shared__ __attribute__((aligned(16))) unsigned char lds_raw[];
    LAS unsigned char* lds = (LAS unsigned char*)lds_raw;
    asm volatile("s_setreg_imm32_b32 hwreg(HW_REG_MODE, 23, 1), 1");
    const int wave0 = __builtin_amdgcn_readfirstlane((int)threadIdx.x >> 6);
    if (wave0 == 0) ((LAS unsigned*)(lds + LDS_CTL))[lane_id()] = 0u;
    __syncthreads();
    constexpr bool MULTI = (KMASK & (KMASK - 1)) != 0;
    XcdBarrier bar; { CArgsP ap_ = (CArgsP)(unsigned long long)__builtin_amdgcn_kernarg_segment_ptr(); unsigned char* const ws = ap_->ws; bar.bar = ctl + CW_BAR; bar.x = 0; bar.st = nullptr; bar.w = wave0;
        if (MULTI) bar = xcd_barrier_post(ctl + CW_BAR, (volatile LAS unsigned*)(lds + LDS_CTL), wave0); }
#define IN(k) (((KMASK >> (k)) & 1) != 0)
#define SEAM(k) do { if (MULTI) xcd_barrier(bar); } while (0)

    if (IN(10)) for (int rep_ = 0; rep_ < NREP(10); ++rep_) {
        PH_BEGIN;
        LAS float* scr = (LAS float*)(lds + wave * 17408);
        constexpr int I_GU = (GU_FP8 ? 8 : 16) * 64, I_DN = (DN_FP8 ? 8 : 16) * 32, I_IN = 16 * 61, I_O = 16 * 32, I_UQ = 4 * 24, I_UKV = 2 * 32;
        constexpr int S_GU = DEPTH * NEXP * I_GU, S_DN = DEPTH * NEXP * I_DN, S_IN = DEPTH * I_IN, S_O = DEPTH * I_O, S_UQ = DEPTH * I_UQ, S_UKV = DEPTH * I_UKV;
        constexpr int NITEMS = S_GU + S_DN + S_IN + S_O + S_UQ + S_UKV;
        for (int it = (BG_CONV ? S_GU + S_DN : 0) + gw; it < NITEMS; it += NGW) {
            int r = it;
            if (r < S_GU) { const int mi = r / I_GU; if (GU_FP8) cvt_item_fp8_k128(w_gu + (size_t)mi * 1024 * 2048, 1024, 2048, WguT + (size_t)mi * 2048 * 1024, scr, r % I_GU, lane, MapWgu{}, W_SCALE); else cvt_item(w_gu + (size_t)mi * 1024 * 2048, 1024, 2048, (bf16*)WguT + (size_t)mi * 2048 * 1024, scr, r % I_GU, lane, MapWgu{}); continue; } r -= S_GU;
            if (r < S_DN) { const int mi = r / I_DN; if (DN_FP8) cvt_item_fp8_k128(w_dn + (size_t)mi * 1024 * 1024, 1024, 1024, WdnT + (size_t)mi * 1024 * 1024, scr, r % I_DN, lane, MapIdent{}, W_SCALE); else cvt_item(w_dn + (size_t)mi * 1024 * 1024, 1024, 1024, (bf16*)WdnT + (size_t)mi * 1024 * 1024, scr, r % I_DN, lane, MapIdent{}); continue; } r -= S_DN;
            if (r < S_IN) { const int l = r / I_IN; if (DG_FP8) cvt_item_fp8(w_in + (size_t)l * 1024 * D_IN, 1024, D_IN, (unsigned char*)WinT + (size_t)l * NPROJ * 1024, scr, r % I_IN, lane, MapWin{}, W_SCALE); else if (NORM_FOLD) cvt_item(w_in + (size_t)l * 1024 * D_IN, 1024, D_IN, WinT + (size_t)l * NPROJ * 1024, scr, r % I_IN, lane, MapWinG{attn_norm + (size_t)l * DM}); else cvt_item(w_in + (size_t)l * 1024 * D_IN, 1024, D_IN, WinT + (size_t)l * NPROJ * 1024, scr, r % I_IN, lane, MapWin{}); continue; } r -= S_IN;
            if (r < S_O) { const int l = r / I_O; if (DG_FP8) cvt_item_fp8(w_o + (size_t)l * 1024 * 1024, 1024, 1024, (unsigned char*)WoT + (size_t)l * 1024 * 1024, scr, r % I_O, lane, MapIdent{}, W_SCALE); else if (MIX_FUSED) cvt_item(w_o + (size_t)l * 1024 * 1024, 1024, 1024, WoT + (size_t)l * 1024 * 1024, scr, r % I_O, lane, MapKG{mix_norm + l * 1024}); else cvt_item(w_o + (size_t)l * 1024 * 1024, 1024, 1024, WoT + (size_t)l * 1024 * 1024, scr, r % I_O, lane, MapIdent{}); continue; } r -= S_O;
            if (r < S_UQ) { const int l = r / I_UQ; cvt_item(w_uq + (size_t)l * 256 * 768, 256, 768, WuqT + (size_t)l * 768 * 256, scr, r % I_UQ, lane, MapWuq{q_norm + l * 256}); continue; } r -= S_UQ;
            { const int l = r / I_UKV; cvt_item(w_ukv + (size_t)l * 128 * 1024, 128, 1024, WukvT + (size_t)l * 1024 * 128, scr, r % I_UKV, lane, MapKG{kv_norm + l * 128}); }
        }
        for (int i = bx * 512 + tid; i < DEPTH * 96 * 128; i += G * 512) { const int l = i / (96 * 128), rr = i % (96 * 128);
            if (DG_FP8) { if (rr < 96 * 64) *(u32x4*)((unsigned char*)WinT + (size_t)l * NPROJ * 1024 + (size_t)416 * 1024 + (size_t)rr * 16) = (u32x4){0u, 0u, 0u, 0u}; }
            else *(u32x4*)(WinT + (size_t)l * NPROJ * 1024 + (size_t)416 * 1024 + (size_t)rr * 8) = (u32x4){0u, 0u, 0u, 0u}; }
        for (int i = bx * 512 + tid; i < DEPTH * 32 * 2 * 64; i += G * 512) { const int ln = i & 63, blk = (i >> 6) & 1, s = (i >> 7) & 31, l = i >> 12;
            const int e = 16 * blk + (ln & 15), k0 = 32 * s + 8 * (ln >> 4);
            const float* wp = w_router + ((size_t)l * DM + k0) * NEXP + e; const float* gp = ffn_norm + (size_t)l * DM + k0;
            unsigned hi[4], lo[4];
#pragma unroll
            for (int j = 0; j < 4; ++j) { const float a = wp[(2 * j) * NEXP] * gp[2 * j], b = wp[(2 * j + 1) * NEXP] * gp[2 * j + 1];
                hi[j] = cvtpk(a, b); lo[j] = cvtpk(a - bf_lo(hi[j]), b - bf_hi(hi[j])); }
            u32x4* dst = (u32x4*)(ws + WS_WRT) + (size_t)(((l * 32 + s) * 2 + blk) * 2) * 64 + ln;
            dst[0] = (u32x4){hi[0], hi[1], hi[2], hi[3]}; dst[64] = (u32x4){lo[0], lo[1], lo[2], lo[3]}; }
        for (int i = bx * 512 + tid; i < NTOK * 16; i += G * 512) { const int row = i >> 4, fi = i & 15;
            const float inv = exp2f(-(float)fi * 0.8304820237218406f); const float ang = (float)positions[row] * inv;
            const double rev = (double)ang * 0.15915494309189535; const float fr = (float)(rev - rint(rev));
            ropecs[i] = (f32x2){__builtin_amdgcn_cosf(fr), __builtin_amdgcn_sinf(fr)}; }
        for (int row0 = gw; row0 < NTOK; row0 += 4 * NGW) {
            f32x4 v[4][4];
#pragma unroll
            for (int t = 0; t < 4; ++t) { const int row = row0 + t * NGW; const float* xr = x_in + (size_t)(row < NTOK ? row : row0) * DM;
#pragma unroll
                for (int j = 0; j < 2; ++j) { v[t][2 * j] = __builtin_nontemporal_load((const f32x4*)(xr + 8 * lane + 512 * j)); v[t][2 * j + 1] = __builtin_nontemporal_load((const f32x4*)(xr + 8 * lane + 512 * j + 4)); } }
#pragma unroll
            for (int t = 0; t < 4; ++t) { const int row = row0 + t * NGW;
                const float rs = rsqrtf(wave_sum(sumsq4(v[t]), lane) * (1.f / DM) + RMS_EPS);
                if (row < NTOK) { if (DG_FP8) norm_store_fp8(v[t], rs, attn_norm, H8 + (size_t)row * DM, lane, H_SCALE);
                    else if (NORM_FOLD) { bf16* x16 = R16 + (size_t)row * DM;
#pragma unroll
                        for (int j = 0; j < 2; ++j) *(u32x4*)(x16 + 8 * lane + 512 * j) = (u32x4){cvtpk(v[t][2 * j][0], v[t][2 * j][1]), cvtpk(v[t][2 * j][2], v[t][2 * j][3]), cvtpk(v[t][2 * j + 1][0], v[t][2 * j + 1][1]), cvtpk(v[t][2 * j + 1][2], v[t][2 * j + 1][3])};
                        if (lane == 0) ((float*)(ws + WS_RSIN))[row] = rs; }
                    else norm_store_bf16(v[t], rs, attn_norm, Hb + (size_t)row * DM, lane); } }
        }
    }
    SEAM(10);

    if constexpr (L0 < L1) layer_body<KMASK, L0>(lds, bar);
    if constexpr (L0 + 1 < L1) layer_body<KMASK, L0 + 1>(lds, bar);
    static_assert(L1 - L0 <= 2, "two layers");
#undef IN
#undef SEAM
}

extern "C" void kernel_launch(void* const* d_in, const int* in_sizes, int n_in, void* d_out, int out_size, void* d_ws, size_t ws_size, hipStream_t stream) {
    static int grid = 0;
    if (grid == 0) {
        if (n_in != 19 || out_size != NTOK * DM || ws_size < WS_END) { fprintf(stderr, "kernel_launch: unexpected shapes (n_in %d, out %d, ws %zu < %zu)\n", n_in, out_size, ws_size, (size_t)WS_END); grid = -1; return; }
        int dev = 0, cus = 0, per_cu = 0;
        if (hipGetDevice(&dev) != hipSuccess || hipDeviceGetAttribute(&cus, hipDeviceAttributeMultiprocessorCount, dev) != hipSuccess) { grid = -1; return; }
#if MK_PER_PHASE
#define SETATTR1(MASK, L) ok = ok && (hipFuncSetAttribute((const void*)mk_fwd<MASK, L, L + 1>, hipFuncAttributeMaxDynamicSharedMemorySize, LDS_BYTES) == hipSuccess)
#define SETATTR(MASK) SETATTR1(MASK, 0); SETATTR1(MASK, 1)
        bool ok = (hipFuncSetAttribute((const void*)mk_fwd<0x400, 0, 0>, hipFuncAttributeMaxDynamicSharedMemorySize, LDS_BYTES) == hipSuccess);
        SETATTR(0x001); SETATTR(0x002); SETATTR(0x004); SETATTR(0x008); SETATTR(0x010); SETATTR(0x020); SETATTR(0x040); SETATTR(0x080); SETATTR(0x100); SETATTR(0x200);
        if (!ok) { fprintf(stderr, "kernel_launch: hipFuncSetAttribute failed\n"); grid = -1; return; }
        per_cu = 1;
#else
        if (hipFuncSetAttribute((const void*)mk_fwd<0x7FF, 0, DEPTH>, hipFuncAttributeMaxDynamicSharedMemorySize, LDS_BYTES) != hipSuccess) { fprintf(stderr, "kernel_launch: hipFuncSetAttribute failed\n"); grid = -1; return; }
        if (hipOccupancyMaxActiveBlocksPerMultiprocessor(&per_cu, (const void*)mk_fwd<0x7FF, 0, DEPTH>, NWAVES * 64, LDS_BYTES) != hipSuccess || per_cu < 1)
            fprintf(stderr, "kernel_launch: occupancy query reports %d workgroups per CU\n", per_cu);
#endif
        (void)hipGetLastError();
        grid = cus;
    }
    if (grid < 0) return;
    if (hipMemsetAsync((char*)d_ws + WS_CTL, 0, CTL_ZERO_BYTES, stream) != hipSuccess) return;
    Args a{};
    for (int i = 0; i < 19; ++i) a.in[i] = (const float*)d_in[i];
    a.out = (float*)d_out; a.ws = (unsigned char*)d_ws;
#if MK_PER_PHASE
#define LAUNCH1(MASK, L) hipLaunchKernelGGL((mk_fwd<MASK, L, L + 1>), dim3(grid), dim3(NWAVES * 64), LDS_BYTES, stream, a)
#define LAUNCHL(L) do { LAUNCH1(0x001, L); LAUNCH1(0x002, L); LAUNCH1(0x004, L); LAUNCH1(0x008, L); LAUNCH1(0x010, L); LAUNCH1(0x020, L); LAUNCH1(0x040, L); LAUNCH1(0x080, L); LAUNCH1(0x100, L); LAUNCH1(0x200, L); } while (0)
    hipLaunchKernelGGL((mk_fwd<0x400, 0, 0>), dim3(grid), dim3(NWAVES * 64), LDS_BYTES, stream, a);
    LAUNCHL(0); LAUNCHL(1);
#else
    hipLaunchKernelGGL((mk_fwd<0x7FF, 0, DEPTH>), dim3(grid), dim3(NWAVES * 64), LDS_BYTES, stream, a);
#endif
    const hipError_t le = hipPeekAtLastError();
    if (le != hipSuccess) fprintf(stderr, "kernel_launch: launch failed: %s\n", hipGetErrorName(le));
}
```

```cpp
#include <hip/hip_runtime.h>
#include <cstdio>
#include <cstdint>

#ifndef GU_FP8
#define GU_FP8 1
#endif
#ifndef BG_CONV
#define BG_CONV 1
#endif
#ifndef DMA_IN_MMA
#define DMA_IN_MMA 0
#endif
#ifndef PREP_FUSED
#define PREP_FUSED 1
#endif
#ifndef YS_FP8
#define YS_FP8 1
#endif
#ifndef MIX_FUSED
#define MIX_FUSED 1
#endif
#ifndef DG_FP8
#define DG_FP8 0
#endif
#ifndef DN_FP8
#define DN_FP8 1
#endif
#ifndef NORM_FOLD
#define NORM_FOLD 1
#endif
#ifndef GEMM_PRIO
#define GEMM_PRIO 0
#endif
#ifndef MK_PER_PHASE
#define MK_PER_PHASE 0
#endif

#define GAS __attribute__((address_space(1)))
#define LAS __attribute__((address_space(3)))
typedef unsigned short bf16;
typedef short bf16x8 __attribute__((ext_vector_type(8)));
typedef short s16x4 __attribute__((ext_vector_type(4)));
typedef float f32x2 __attribute__((ext_vector_type(2)));
typedef float f32x4 __attribute__((ext_vector_type(4)));
typedef float f32x16 __attribute__((ext_vector_type(16)));
typedef unsigned u32x2 __attribute__((ext_vector_type(2)));
typedef unsigned u32x4 __attribute__((ext_vector_type(4)));
typedef __bf16 bf16x2_t __attribute__((ext_vector_type(2)));
typedef short v4i16_t __attribute__((ext_vector_type(4)));

constexpr int NTOK = 32768, SEQ = 2048, DM = 1024, DEPTH = 2;
constexpr int D_IN = 1952, NPROJ = 2048;
constexpr int NEXP = 32, TOPK = 4;
constexpr int NWAVES = 8;
constexpr float RMS_EPS = 1e-6f;
constexpr float LOG2E = 1.4426950408889634f;
constexpr int PC_CQ = 0, PC_CKV = 256, PC_KPE = 384, PC_SBQ = 512, PC_SBK = 768, PC_SBV = 1024, PC_CAQ = 1280, PC_CAK = 1536, PC_CAV = 1792;

constexpr size_t MiB = 1u << 20;
constexpr size_t WS_CTL = 0, CTL_ZERO_BYTES = 1 * MiB;
constexpr size_t WS_WIN = 2 * MiB;
constexpr size_t WS_WUQ = WS_WIN + 8 * MiB;
constexpr size_t WS_WUKV = WS_WUQ + 1 * MiB;
constexpr size_t WS_WO = WS_WUKV + 1 * MiB;
constexpr size_t WS_ROPE = WS_WO + 4 * MiB;
constexpr size_t WS_RSTD = WS_ROPE + 4 * MiB;
constexpr size_t WS_KPE = WS_RSTD + 1 * MiB;
constexpr size_t WS_TOK = WS_KPE + 2 * MiB;
constexpr size_t WS_GATE = WS_TOK + 4 * MiB;
constexpr size_t WS_WGU = 32 * MiB;
constexpr size_t WS_WDN = WS_WGU + 256 * MiB;
constexpr size_t WS_H = WS_WDN + 128 * MiB;
constexpr size_t WS_PROJ = WS_H + 64 * MiB;
constexpr size_t WS_QB = WS_PROJ + 128 * MiB;
constexpr size_t WS_KVB = WS_QB + 48 * MiB;
constexpr size_t WS_MIXED = WS_KVB + 64 * MiB;
constexpr size_t WS_ACT = WS_MIXED + 64 * MiB;
constexpr size_t WS_YS = WS_ACT + 272 * MiB;
constexpr size_t WS_H8 = WS_YS + 256 * MiB;
constexpr size_t WS_R16 = WS_H8 + 32 * MiB;
constexpr size_t WS_MSTAT = WS_R16 + 64 * MiB;
constexpr size_t WS_END = WS_MSTAT + 4 * MiB;
constexpr float W_SCALE = 64.f, H_SCALE = 8.f, ACT_SCALE = 4.f, YS_SCALE = 32.f;
constexpr size_t WS_WRT = WS_GATE + 4 * MiB;
constexpr size_t WS_RSIN = WS_WRT + 512 * 1024;
static_assert(WS_WRT + 1 * MiB <= WS_WGU, "ws map");
constexpr int CW_BAR = 4096;
constexpr int CW_CNT = 16384;

constexpr int LDS_BYTES = 163840;
constexpr int LDS_MISC = 147456;
constexpr int LDS_CTL = 163584;
constexpr int GEMM_SLOT0 = 131072, GEMM_SLOT_BYTES = 3072;

#define LDS_WAIT() asm volatile("s_waitcnt lgkmcnt(0)" ::: "memory")
#define VM_WAIT() asm volatile("s_waitcnt vmcnt(0)" ::: "memory")
__device__ __forceinline__ unsigned cvtpk(float lo, float hi) { f32x2 v = {lo, hi}; bf16x2_t b = __builtin_convertvector(v, bf16x2_t); return __builtin_bit_cast(unsigned, b); }
__device__ __forceinline__ unsigned pk4_fp8(float a, float b, float c, float d) { int v = 0; v = __builtin_amdgcn_cvt_pk_fp8_f32(a, b, v, false); v = __builtin_amdgcn_cvt_pk_fp8_f32(c, d, v, true); return (unsigned)v; }
__device__ __forceinline__ unsigned pk4_fp8_sat(float a, float b, float c, float d) { return pk4_fp8(a, b, c, d); }
typedef short s16x2_t __attribute__((ext_vector_type(2)));
__device__ __forceinline__ unsigned pk4_fp8_scaled(float a, float b, float c, float d, float inv_scale) {
    s16x2_t r = __builtin_amdgcn_cvt_scalef32_pk_fp8_f32((s16x2_t){0, 0}, a, b, inv_scale, false);
    r = __builtin_amdgcn_cvt_scalef32_pk_fp8_f32(r, c, d, inv_scale, true);
    return __builtin_bit_cast(unsigned, r); }
__device__ __forceinline__ float bf_lo(unsigned u) { return __builtin_bit_cast(float, u << 16); }
__device__ __forceinline__ float bf_hi(unsigned u) { return __builtin_bit_cast(float, u & 0xffff0000u); }
#define SWZ_I(x, k) __builtin_amdgcn_ds_swizzle((x), ((k) << 10) | 0x1F)
#define SWZ_F(x, k) __builtin_bit_cast(float, __builtin_amdgcn_ds_swizzle(__builtin_bit_cast(int, (x)), ((k) << 10) | 0x1F))
__device__ __forceinline__ float x32_sum(float a, float b) {
    auto rr = __builtin_amdgcn_permlane32_swap(__builtin_bit_cast(unsigned, a), __builtin_bit_cast(unsigned, b), false, false);
    return __builtin_bit_cast(float, rr[0]) + __builtin_bit_cast(float, rr[1]); }
__device__ __forceinline__ float x32_max(float a) {
    auto rr = __builtin_amdgcn_permlane32_swap(__builtin_bit_cast(unsigned, a), __builtin_bit_cast(unsigned, a), false, false);
    return fmaxf(__builtin_bit_cast(float, rr[0]), __builtin_bit_cast(float, rr[1])); }
__device__ __forceinline__ int x32_maxi(int a) {
    auto rr = __builtin_amdgcn_permlane32_swap((unsigned)a, (unsigned)a, false, false);
    const int u = (int)rr[0], v = (int)rr[1]; return u > v ? u : v; }
__device__ __forceinline__ float shx(float v, int lane, int k) { return __builtin_bit_cast(float, __builtin_amdgcn_ds_bpermute((lane ^ k) << 2, __builtin_bit_cast(int, v))); }
__device__ __forceinline__ int shxi(int v, int lane, int k) { return __builtin_amdgcn_ds_bpermute((lane ^ k) << 2, v); }
__device__ __forceinline__ float wave_sum(float v, int lane) {
    v += shx(v, lane, 1); v += shx(v, lane, 2); v += shx(v, lane, 4); v += shx(v, lane, 8); v += shx(v, lane, 16); v += shx(v, lane, 32);
    return v;
}
#ifndef WT_STORES
#define WT_STORES 1
#endif
__device__ __forceinline__ void st16_wt(void* p, u32x4 v) { if (WT_STORES) asm volatile("global_store_dwordx4 %0, %1, off sc1\n\ts_nop 3" :: "v"(p), "v"(v) : "memory"); else *(u32x4*)p = v; }
__device__ __forceinline__ float ex2(float x) { return __builtin_amdgcn_exp2f(x); }
__device__ __forceinline__ float lg2(float x) { return __builtin_amdgcn_logf(x); }
#define MFMA32(a, b, c) __builtin_amdgcn_mfma_f32_32x32x16_bf16((a), (b), (c), 0, 0, 0)
#define MFMA16(a, b, c) __builtin_amdgcn_mfma_f32_16x16x32_bf16((a), (b), (c), 0, 0, 0)

#define XB_TMO      128
#define XB_XCNT(j)  (256  + 64 * (j))
#define XB_XSUB(j)  (1280 + 64 * (j))
#define XB_XGEN(j)  (2304 + 64 * (j))
#define XB_TOP      3328
#define XB_TOPGEN   3392
#define XCD_BAR_WORDS 3456
#define XB_SPIN_CAP (1u << 18)
__device__ __forceinline__ unsigned xb_ld(unsigned* p)              { return __hip_atomic_load(p, __ATOMIC_RELAXED, __HIP_MEMORY_SCOPE_AGENT); }
__device__ __forceinline__ unsigned xb_add(unsigned* p, unsigned v) { return __hip_atomic_fetch_add(p, v, __ATOMIC_RELAXED, __HIP_MEMORY_SCOPE_AGENT); }
__device__ __forceinline__ unsigned xb_xcc_id() { return (unsigned)__builtin_amdgcn_s_getreg((3 << 11) | 20) & 0xFu; }
#define XB_SPIN(cond, bar) do { unsigned _sp = 0; while (cond) { __builtin_amdgcn_s_sleep(1); \
    if ((++_sp & 255u) == 0u) { if (xb_ld(&(bar)[XB_TMO])) break; if (_sp > XB_SPIN_CAP) { atomicAdd(&(bar)[XB_TMO], 1u); break; } } } } while (0)
struct XcdBarrier { unsigned* bar; unsigned x; volatile LAS unsigned* st; int w; };
__device__ __forceinline__ int lane_id() { int r; asm volatile("v_mbcnt_lo_u32_b32 %0, -1, 0\n\tv_mbcnt_hi_u32_b32 %0, -1, %0" : "=v"(r)); return r; }
__device__ __forceinline__ XcdBarrier xcd_barrier_post(unsigned* bar, volatile LAS unsigned* st, int w) {
    XcdBarrier b; b.bar = bar; b.x = xb_xcc_id(); b.st = st; b.w = w;
    if (w == 0 && lane_id() == 0) (void)xb_add(&bar[XB_XCNT(b.x)], 1u);
    return b;
}
__device__ __forceinline__ void xcd_barrier_complete(unsigned* bar, unsigned x, unsigned& nloc, unsigned& nx) {
    const unsigned G = gridDim.x * gridDim.y * gridDim.z;
    unsigned sum, cnt, mine, sp = 0u;
    for (;;) {
        sum = 0u; cnt = 0u; mine = 0u;
#pragma unroll
        for (unsigned j = 0; j < 16; ++j) { const unsigned c = xb_ld(&bar[XB_XCNT(j)]); sum += c; cnt += (c > 0u) ? 1u : 0u; mine = (j == x) ? c : mine; }
        if (sum == G) break;
        __builtin_amdgcn_s_sleep(1);
        if ((++sp & 255u) == 0u) { if (xb_ld(&bar[XB_TMO])) break; if (sp > XB_SPIN_CAP) { atomicAdd(&bar[XB_TMO], 1u); break; } }
    }
    nloc = mine > 0u ? mine : 1u; nx = cnt > 0u ? cnt : 1u;
}
__device__ __forceinline__ void xcd_barrier(const XcdBarrier& b) {
    asm volatile("s_waitcnt vmcnt(0)" ::: "memory");
    __syncthreads();
    if (b.w == 0 && lane_id() == 0) {
        unsigned* bar = b.bar; unsigned bx_ = b.x; asm volatile("" : "+s"(bar), "+s"(bx_));
        __builtin_amdgcn_s_waitcnt(0);
        unsigned nloc = b.st[0], nx = b.st[1];
        if (nloc == 0u) { xcd_barrier_complete(bar, bx_, nloc, nx); b.st[0] = nloc; b.st[1] = nx; }
        const unsigned old = xb_add(&bar[XB_XSUB(bx_)], 1u);
        const unsigned gen = old / nloc;
        if (old + 1u == (gen + 1u) * nloc) {
            __builtin_amdgcn_fence(__ATOMIC_RELEASE, "agent");
            asm volatile("s_waitcnt vmcnt(0)" ::: "memory");
            const unsigned og = xb_add(&bar[XB_TOP], 1u);
            const unsigned tg = og / nx;
            if (og + 1u == (tg + 1u) * nx) xb_add(&bar[XB_TOPGEN], 1u);
            else XB_SPIN(xb_ld(&bar[XB_TOPGEN]) == tg, bar);
            __builtin_amdgcn_fence(__ATOMIC_ACQUIRE, "agent");
            xb_add(&bar[XB_XGEN(bx_)], 1u);
            asm volatile("s_waitcnt vmcnt(0)" ::: "memory");
        } else {
            XB_SPIN(xb_ld(&bar[XB_XGEN(bx_)]) == gen, bar);
            __builtin_amdgcn_fence(__ATOMIC_ACQUIRE, "agent");
            asm volatile("s_waitcnt vmcnt(0)" ::: "memory");
        }
    }
    __syncthreads();
}

namespace pg8 {
constexpr int BM = 256, BK = 64, HALF = 128, HTB = HALF * BK * 2, STAGE_BYTES = 8 * HTB, NXCD = 8, WGM = 8;
__host__ __device__ __forceinline__ int lds_byte(int r, int c) { const int st = (r >> 4) * 2 + (c >> 5), rr = r & 15, cc = c & 31, ob = rr * 64 + cc * 2; return st * 1024 + (ob ^ (((ob >> 9) & 1) << 5)); }
__host__ __device__ __forceinline__ void stage_rc(int b, int& R, int& C) { const int st = b / 1024, sb = b % 1024, swz = sb ^ (((sb >> 9) & 1) << 5); R = (st >> 1) * 16 + swz / 64; C = (st & 1) * 32 + (swz % 64) / 2; }
__host__ __device__ __forceinline__ int perm32(int rho) { const int n = rho >> 4, i = rho & 15; return 8 * (i >> 2) + 4 * n + (i & 3); }
struct Unit { int pm, pn, e, nvalid, mt; };

typedef int v4i_t __attribute__((ext_vector_type(4)));
typedef int v8i_t __attribute__((ext_vector_type(8)));
template <class Epi, class Sched, bool FP8 = false>
__device__ __forceinline__ void gemm_phase(const int tid, LAS unsigned char* lds, const void* Ab, const void* Btb, const int KB_in, const Sched S, const Epi E) {
    int KB = KB_in; asm volatile("" : "+s"(KB));
    const int wid = __builtin_amdgcn_readfirstlane(tid >> 6), lane = tid & 63, wr = wid >> 2, wc = wid & 3, fr = lane & 15, fq = lane >> 4;
    const int nt = KB / (BK * 2);
    constexpr bool GATHER = Sched::GATHER;
    unsigned voffB[2], va[GATHER ? 2 : 1][2];
#pragma unroll
    for (int i = 0; i < 2; ++i) { int R, C; stage_rc(tid * 16 + i * 8192, R, C); const int Rb = (R & ~31) + perm32(R & 31); voffB[i] = (unsigned)(Rb * KB) + (unsigned)C * 2u;
        if constexpr (!GATHER) va[0][i] = (unsigned)R * S.pitchB + S.colB + (unsigned)C * 2u; }
    const size_t kstep = (size_t)(BK * 2);
    const size_t hstepB = (size_t)HALF * KB;
    const size_t tstepB = 2 * hstepB;
    const unsigned ldsw = (unsigned)wid * 1024u;
    const unsigned lds0 = (unsigned)(unsigned long long)lds;
    const int aoffL = lds_byte(wr * 64 + fr, fq * 8), boffL = lds_byte(wc * 32 + fr, fq * 8);
#define PG8_SA(b, h) (((b) * 2 + (h)) * HTB)
#define PG8_SB(b, h) ((4 + (b) * 2 + (h)) * HTB)
#define PG8_GLDS(sbase, voff, ldsdst) do { unsigned keep_; asm volatile("s_mov_b32 %0, m0\n\ts_mov_b32 m0, %3\n\ts_nop 0\n\tglobal_load_lds_dwordx4 %1, %2\n\ts_mov_b32 m0, %0" \
        : "=&s"(keep_) : "v"(voff), "s"(sbase), "s"(ldsdst) : "memory"); } while (0)
#define PG8_STAGE_B(bufoff, gbase) do { _Pragma("unroll") for (int _i = 0; _i < 2; ++_i) \
        PG8_GLDS((const char*)(gbase), voffB[_i], lds0 + (unsigned)(bufoff) + ldsw + (unsigned)_i * 8192u); } while (0)
#define PG8_STAGE_A(bufoff, kb, h) do { _Pragma("unroll") for (int _i = 0; _i < 2; ++_i) \
        PG8_GLDS(cA + (GATHER ? (size_t)0 : (size_t)(h) * hstepA) + (size_t)(kb), va[GATHER ? (h) : 0][_i], lds0 + (unsigned)(bufoff) + ldsw + (unsigned)_i * 8192u); } while (0)
#define PG8_LD8(p) __builtin_shufflevector(*(const LAS v4i_t*)(p), *(const LAS v4i_t*)((p) + 1024), 0, 1, 2, 3, 4, 5, 6, 7)
#define PG8_LDA(dst, b, h) do { _Pragma("unroll") for (int m = 0; m < 4; ++m) dst[m] = PG8_LD8(lds + PG8_SA(b, h) + aoffL + m * 2048); } while (0)
#define PG8_LDB(dst, b, h) do { _Pragma("unroll") for (int n = 0; n < 2; ++n) dst[n] = PG8_LD8(lds + PG8_SB(b, h) + boffL + n * 2048); } while (0)
#define PG8_HALF(x, k) __builtin_bit_cast(bf16x8, __builtin_shufflevector((x), (x), 4 * (k), 4 * (k) + 1, 4 * (k) + 2, 4 * (k) + 3))
#define PG8_MMA(ai, bj, At, Bt) do { if (GEMM_PRIO == 1) __builtin_amdgcn_s_setprio(1); _Pragma("unroll") for (int m = 0; m < 4; ++m) _Pragma("unroll") for (int n = 0; n < 2; ++n) { \
        if constexpr (FP8) acc[ai][bj][m][n] = __builtin_amdgcn_mfma_scale_f32_16x16x128_f8f6f4(Bt[n], At[m], acc[ai][bj][m][n], 0, 0, 0, one_scale, 0, one_scale); \
        else { acc[ai][bj][m][n] = __builtin_amdgcn_mfma_f32_16x16x32_bf16(PG8_HALF(Bt[n], 0), PG8_HALF(At[m], 0), acc[ai][bj][m][n], 0, 0, 0); \
               acc[ai][bj][m][n] = __builtin_amdgcn_mfma_f32_16x16x32_bf16(PG8_HALF(Bt[n], 1), PG8_HALF(At[m], 1), acc[ai][bj][m][n], 0, 0, 0); } } \
        if (GEMM_PRIO == 1) __builtin_amdgcn_s_setprio(0); } while (0)
#define PG8_MMA_Z0(ai, bj, At, Bt) do { if (GEMM_PRIO == 1) __builtin_amdgcn_s_setprio(1); _Pragma("unroll") for (int m = 0; m < 4; ++m) _Pragma("unroll") for (int n = 0; n < 2; ++n) { \
        if constexpr (FP8) acc[ai][bj][m][n] = __builtin_amdgcn_mfma_scale_f32_16x16x128_f8f6f4(Bt[n], At[m], (f32x4){0.f, 0.f, 0.f, 0.f}, 0, 0, 0, one_scale, 0, one_scale); \
        else { acc[ai][bj][m][n] = __builtin_amdgcn_mfma_f32_16x16x32_bf16(PG8_HALF(Bt[n], 0), PG8_HALF(At[m], 0), (f32x4){0.f, 0.f, 0.f, 0.f}, 0, 0, 0); \
               acc[ai][bj][m][n] = __builtin_amdgcn_mfma_f32_16x16x32_bf16(PG8_HALF(Bt[n], 1), PG8_HALF(At[m], 1), acc[ai][bj][m][n], 0, 0, 0); } } \
        if (GEMM_PRIO == 1) __builtin_amdgcn_s_setprio(0); } while (0)
#define PG8_MMA_H(ai, bj, At, Bt, H0, H2) do { if (GEMM_PRIO == 1) __builtin_amdgcn_s_setprio(1); _Pragma("unroll") for (int m = 0; m < 4; ++m) { _Pragma("unroll") for (int n = 0; n < 2; ++n) { \
        if constexpr (FP8) acc[ai][bj][m][n] = __builtin_amdgcn_mfma_scale_f32_16x16x128_f8f6f4(Bt[n], At[m], acc[ai][bj][m][n], 0, 0, 0, one_scale, 0, one_scale); \
        else { acc[ai][bj][m][n] = __builtin_amdgcn_mfma_f32_16x16x32_bf16(PG8_HALF(Bt[n], 0), PG8_HALF(At[m], 0), acc[ai][bj][m][n], 0, 0, 0); \
               acc[ai][bj][m][n] = __builtin_amdgcn_mfma_f32_16x16x32_bf16(PG8_HALF(Bt[n], 1), PG8_HALF(At[m], 1), acc[ai][bj][m][n], 0, 0, 0); } } \
        if (m == 0) { __builtin_amdgcn_sched_barrier(0); H0; __builtin_amdgcn_sched_barrier(0); } if (m == 2) { __builtin_amdgcn_sched_barrier(0); H2; __builtin_amdgcn_sched_barrier(0); } } \
        if (GEMM_PRIO == 1) __builtin_amdgcn_s_setprio(0); } while (0)
#define PG8_WAIT_V(n) asm volatile("s_waitcnt vmcnt(" #n ")" ::: "memory")
#define PG8_WAIT_L(n) asm volatile("s_waitcnt lgkmcnt(" #n ")" ::: "memory")
#define PG8_BAR __builtin_amdgcn_s_barrier()
#define PG8_SCHED __builtin_amdgcn_sched_barrier(0)
#define PG8_ROWS(u, slot) do { if constexpr (GATHER) { int tt_ = tid; asm volatile("" : "+v"(tt_)); _Pragma("unroll") for (int i = 0; i < 2; ++i) { int R_, C_; stage_rc(tt_ * 16 + i * 8192, R_, C_); \
        _Pragma("unroll") for (int h = 0; h < 2; ++h) va[h][i] = S.aoff(u, h * HALF + R_, slot) + (unsigned)C_ * 2u; } } } while (0)
    int one_scale = 0x7f7f7f7f; asm volatile("" : "+v"(one_scale));
    Unit cur, nxt; int ui = 0;
    if (!S.next(0, cur)) return;
    if (GEMM_PRIO == 2 && wr == 1) __builtin_amdgcn_s_setprio(1);
    S.prefetch(wid, cur, 0);
    PG8_WAIT_V(0); __syncthreads();
    const size_t hstepA = GATHER ? 0 : (size_t)HALF * S.pitchB;
    const char* cA = (const char*)Ab + (GATHER ? (size_t)0 : (size_t)cur.pm * 2 * hstepA);
    PG8_ROWS(cur, 0);
    f32x4 acc[2][2][4][2];
    if constexpr (Epi::KSCALE) {
#pragma unroll
        for (int a = 0; a < 2; ++a)
#pragma unroll
            for (int b = 0; b < 2; ++b)
#pragma unroll
                for (int m = 0; m < 4; ++m)
#pragma unroll
                    for (int n = 0; n < 2; ++n) acc[a][b][m][n] = (f32x4){0.f, 0.f, 0.f, 0.f}; }
    v8i_t At[4], B0[2], B1[2];
    const char* cB = (const char*)Btb + (size_t)cur.pn * tstepB;
    PG8_STAGE_B(PG8_SB(0, 0), cB); PG8_STAGE_B(PG8_SB(0, 1), cB + hstepB); PG8_STAGE_A(PG8_SA(0, 0), 0, 0); PG8_STAGE_A(PG8_SA(0, 1), 0, 1);
    if (wr == 1) PG8_BAR;
    PG8_WAIT_V(2); PG8_BAR;
    PG8_STAGE_B(PG8_SB(1, 0), cB + kstep); PG8_STAGE_A(PG8_SA(1, 0), kstep, 0); PG8_STAGE_B(PG8_SB(1, 1), cB + hstepB + kstep);
    PG8_WAIT_V(6); PG8_BAR;
    for (;;) {
        const bool has_next = S.next(ui + 1, nxt);
        const int slot_c = ui % 3, slot_n = (ui + 1) % 3;
        if (has_next) S.prefetch(wid, nxt, slot_n);
        const char* nB = has_next ? (const char*)Btb + (size_t)nxt.pn * tstepB : cB;
        const char* nA = (has_next && !GATHER) ? (const char*)Ab + (size_t)nxt.pm * 2 * hstepA : cA;
        float kf[Epi::KSCALE ? 2 : 1][2][4];
        if constexpr (Epi::KSCALE) E.kfactors(cur, wr, lane_id(), kf);
        const bool nv0 = cur.nvalid > wr * 64, nv1 = cur.nvalid > HALF + wr * 64;
#define PG8_KPAIR(MM0, ZE) do { \
            const bool last = (t == nt - 2); \
            const size_t ka1 = (size_t)(t + 1) * kstep; \
            const size_t ka2 = last ? 0 : (size_t)(t + 2) * kstep, ka3 = ka2 + kstep; \
            const char* b2 = last ? nB : cB + (size_t)(t + 2) * kstep; const char* b3 = b2 + kstep; \
              \
            PG8_LDB(B0, 0, 0); PG8_LDB(B1, 0, 1); PG8_SCHED; PG8_LDA(At, 0, 0); PG8_STAGE_A(PG8_SA(1, 1), ka1, 1); \
            PG8_WAIT_V(8); PG8_WAIT_L(0); PG8_BAR; if (nv0) { MM0(0, 0, At, B0); MM0(0, 1, At, B1); } else { ZE(0); } PG8_BAR; PG8_SCHED; \
            if (last) {             \
                cA = nA; \
                if (has_next) PG8_ROWS(nxt, slot_n); \
            } \
              \
            PG8_LDA(At, 0, 1); PG8_STAGE_B(PG8_SB(0, 0), b2); PG8_STAGE_B(PG8_SB(0, 1), b2 + hstepB); PG8_STAGE_A(PG8_SA(0, 0), ka2, 0); \
            PG8_WAIT_V(8); PG8_WAIT_L(0); PG8_BAR; if (nv1) { MM0(1, 0, At, B0); MM0(1, 1, At, B1); } else { ZE(1); } PG8_BAR; PG8_SCHED; \
              \
            PG8_LDB(B0, 1, 0); PG8_LDB(B1, 1, 1); PG8_SCHED; PG8_LDA(At, 1, 0); PG8_STAGE_A(PG8_SA(0, 1), ka2, 1); \
            PG8_WAIT_V(8); PG8_WAIT_L(0); PG8_BAR; if (nv0) { PG8_MMA(0, 0, At, B0); PG8_MMA(0, 1, At, B1); } PG8_BAR; PG8_SCHED; \
              \
            PG8_LDA(At, 1, 1); PG8_STAGE_B(PG8_SB(1, 0), b3); PG8_STAGE_B(PG8_SB(1, 1), b3 + hstepB); PG8_STAGE_A(PG8_SA(1, 0), ka3, 0); \
            PG8_WAIT_V(8); PG8_WAIT_L(0); PG8_BAR; if (nv1) { PG8_MMA(1, 0, At, B0); PG8_MMA(1, 1, At, B1); } PG8_BAR; PG8_SCHED; \
        } while (0)
#define PG8_NOP(ai) do { } while (0)
#define PG8_ZERO(ai) do { _Pragma("unroll") for (int b_ = 0; b_ < 2; ++b_) _Pragma("unroll") for (int m_ = 0; m_ < 4; ++m_) _Pragma("unroll") for (int n_ = 0; n_ < 2; ++n_) acc[ai][b_][m_][n_] = (f32x4){0.f, 0.f, 0.f, 0.f}; } while (0)
        static_assert(!DMA_IN_MMA, "the DMA_IN_MMA form of the K-loop was removed with the accumulator-zeroing change");
        if constexpr (!Epi::KSCALE) { const int t = 0; PG8_KPAIR(PG8_MMA_Z0, PG8_ZERO); }
        for (int t = Epi::KSCALE ? 0 : 2; t < nt; t += 2) {
            if constexpr (Epi::KSCALE) { if (t == 8 || t == 12) { const int w_ = (t == 8) ? 0 : 1;
#pragma unroll
                for (int a = 0; a < 2; ++a)
#pragma unroll
                    for (int m = 0; m < 4; ++m) { const float f = (w_ == 0) ? kf[0][a][m] : kf[1][a][m];
#pragma unroll
                        for (int b = 0; b < 2; ++b)
#pragma unroll
                            for (int n = 0; n < 2; ++n) acc[a][b][m][n] *= f; } } }
            PG8_KPAIR(PG8_MMA, PG8_NOP);
        }
#undef PG8_KPAIR
#undef PG8_ZERO
#undef PG8_NOP
        if (wr == 0) PG8_BAR;
        { const int l2_ = lane_id();
          E(acc, cur, lds + GEMM_SLOT0 + slot_c * GEMM_SLOT_BYTES, wr, wc, l2_ & 15, l2_ >> 4); }
        if (!has_next) break;
        if constexpr (Epi::KSCALE) {
#pragma unroll
            for (int a = 0; a < 2; ++a)
#pragma unroll
                for (int b = 0; b < 2; ++b)
#pragma unroll
                    for (int m = 0; m < 4; ++m)
#pragma unroll
                        for (int n = 0; n < 2; ++n) acc[a][b][m][n] = (f32x4){0.f, 0.f, 0.f, 0.f}; }
        cur = nxt; cB = nB; ++ui;
        if (wr == 1) PG8_BAR;
    }
    PG8_WAIT_V(0);
    PG8_BAR;
    if (GEMM_PRIO == 2) __builtin_amdgcn_s_setprio(0);
#undef PG8_SA
#undef PG8_SB
#undef PG8_STAGE_A
#undef PG8_GLDS
#undef PG8_STAGE_B
#undef PG8_LDA
#undef PG8_LDB
#undef PG8_MMA
#undef PG8_MMA_Z0
#undef PG8_MMA_H
#undef PG8_LD8
#undef PG8_HALF
#undef PG8_WAIT_V
#undef PG8_WAIT_L
#undef PG8_BAR
#undef PG8_SCHED
#undef PG8_ROWS
}

struct DenseSched {
    static constexpr bool GATHER = false;
    int nM, nN, nwg, G, c; unsigned pitchB, colB; int deal;
    __device__ __forceinline__ void init(int M, int N, int G_, int c_, unsigned pitch_bytes, unsigned col_bytes) { nM = M / BM; nN = N / BM; nwg = nM * nN; G = G_; c = c_; pitchB = pitch_bytes; colB = col_bytes; deal = 0; }
    __device__ __forceinline__ bool next(int i, Unit& u) const {
        int L = i * G + c;
        if (deal == 1) { if (c < 128) { if (i > 0) return false; } else { if (i > 2) return false; L = (i == 0) ? c : 128 + 128 * i + (c - 128); } }
        if (L >= nwg) return false;
        int wgid = L; { const int q = nwg / NXCD, r = nwg % NXCD, xcd = wgid % NXCD, off = wgid / NXCD; wgid = (xcd < r ? xcd * (q + 1) : r * (q + 1) + (xcd - r) * q) + off; }
        const int nig = WGM * nN, gid = wgid / nig, fm = gid * WGM, gsz = (nM - fm) < WGM ? (nM - fm) : WGM;
        u.pm = fm + ((wgid % nig) % gsz); u.pn = (wgid % nig) / gsz; u.e = 0; u.nvalid = 256; u.mt = 0; return true;
    }
    __device__ __forceinline__ void prefetch(int, const Unit&, int) const {}
    __device__ __forceinline__ unsigned aoff(const Unit& u, int row, int) const { return (unsigned)(u.pm * BM + row) * pitchB + colB; }
};
template <int MODE>
struct MoeSched {
    static constexpr bool GATHER = (MODE == 0);
    static constexpr int mode = MODE;
    unsigned pitchB, colB;
    LAS const int* pst; LAS const int* cn; LAS unsigned char* slots;
    int NT, G, c, P, nunits;
    const int* tok; const float* gate; const float* bias;
    __device__ __forceinline__ bool next(int i, Unit& u) const {
        const int L = i * G + c; if (L >= nunits) return false;
        const int ln_ = lane_id();
        const int tA_ = pst[ln_ & 63], tB_ = pst[128 + (ln_ & 63)], tC_ = cn[ln_ & 31];
        const int PA = __builtin_amdgcn_readlane(tA_, 32), nA = PA * NT;
        int p, pnl, e = 0, mt, nv;
        if (L < nA) {
            int wgid = L; { const int q = nA / NXCD, r = nA % NXCD, xcd = wgid % NXCD, off = wgid / NXCD; wgid = (xcd < r ? xcd * (q + 1) : r * (q + 1) + (xcd - r) * q) + off; }
            const int nig = WGM * NT, gid = wgid / nig, fm = gid * WGM, gsz = (PA - fm) < WGM ? (PA - fm) : WGM;
            p = fm + ((wgid % nig) % gsz); pnl = (wgid % nig) / gsz;
            e = __builtin_popcountll(__builtin_amdgcn_ballot_w64(ln_ >= 1 && ln_ <= 31 && tA_ <= p));
            mt = p - __builtin_amdgcn_readlane(tA_, e); nv = __builtin_amdgcn_readlane(tC_, e) - mt * 256; nv = nv > 256 ? 256 : nv;
        } else {
            const int wb = L - nA, qb = wb / NT; p = PA + qb; pnl = wb % NT;
            e = __builtin_popcountll(__builtin_amdgcn_ballot_w64(ln_ >= 1 && ln_ <= 31 && tB_ <= qb));
            const int ce = __builtin_amdgcn_readlane(tC_, e);
            mt = ce >> 8; nv = ce & 255;
        }
        u.pm = p; u.pn = e * NT + pnl; u.e = e; u.nvalid = nv; u.mt = mt; return true;
    }
    static __device__ __forceinline__ void glds4(const void* sbase_in, unsigned voff, unsigned ldsdst_in) { unsigned keep_;
        const unsigned long long p_ = (unsigned long long)sbase_in;
        const unsigned long long sbase = ((unsigned long long)(unsigned)__builtin_amdgcn_readfirstlane((int)(p_ >> 32)) << 32) | (unsigned)__builtin_amdgcn_readfirstlane((int)p_);
        const unsigned ldsdst = (unsigned)__builtin_amdgcn_readfirstlane((int)ldsdst_in);
        asm volatile("s_mov_b32 %0, m0\n\ts_mov_b32 m0, %3\n\ts_nop 0\n\tglobal_load_lds_dword %1, %2\n\ts_mov_b32 m0, %0" : "=&s"(keep_) : "v"(voff), "s"(sbase), "s"(ldsdst) : "memory"); }
    __device__ __forceinline__ void prefetch(const int wid, const Unit& u, int s) const {
        const int lane = lane_id();
        const int mt = u.mt, pnl = u.pn - u.e * NT;
        const unsigned sl = (unsigned)(unsigned long long)slots + (unsigned)s * GEMM_SLOT_BYTES;
        const unsigned lo = (unsigned)lane * 4u;
        if (wid < 4) {
            glds4(tok + (size_t)u.e * NTOK + mt * 256 + wid * 64, lo, sl + wid * 256);
        } else {
            const int w2 = wid - 4;
            if (mode == 0) {
                const int col = (w2 < 2) ? (128 * pnl + 64 * w2) : (1024 + 128 * pnl + 64 * (w2 - 2));
                glds4(bias + (size_t)u.e * 2048 + col, lo, sl + 2048 + w2 * 256);
            } else {
                glds4(gate + (size_t)u.e * NTOK + mt * 256 + w2 * 64, lo, sl + 1024 + w2 * 256);
                glds4(bias + (size_t)u.e * 1024 + 256 * pnl + w2 * 64, lo, sl + 2048 + w2 * 256);
            }
        }
    }
    __device__ __forceinline__ unsigned aoff(const Unit& u, int row, int s) const {
        if (mode == 0) { int t = ((LAS const int*)(slots + s * GEMM_SLOT_BYTES))[row]; t = (row < u.nvalid) ? (t >> 2) : 0; return (unsigned)t * pitchB; }
        return (unsigned)(u.pm * 256 + row) * pitchB;
    }
};

struct EpiStore {
    static constexpr bool KSCALE = false;
    bf16* O; int ldc; const float* rs; int rsi; float sc;
    __device__ __forceinline__ void operator()(const f32x4 (&acc)[2][2][4][2], const Unit& u, LAS unsigned char*, int wr, int wc, int fr, int fq) const {
        const int row0 = u.pm * BM + wr * 64 + fr, col0 = u.pn * BM + wc * 32 + 8 * fq;
#pragma unroll
        for (int ai = 0; ai < 2; ++ai)
#pragma unroll
            for (int m = 0; m < 4; ++m) {
                const int row = row0 + ai * HALF + m * 16; float s = sc;
                if (rs) { if (PREP_FUSED) { const f32x4 p = *(const f32x4*)(rs + (size_t)row * 8 + 4); s *= rsqrtf(((p[0] + p[1]) + (p[2] + p[3])) * (1.f / 128.f) + RMS_EPS); } else s *= rs[row * 2 + rsi]; }
                bf16* rowp = O + (size_t)row * ldc + col0;
#pragma unroll
                for (int bj = 0; bj < 2; ++bj) { const f32x4 v0 = acc[ai][bj][m][0] * s, v1 = acc[ai][bj][m][1] * s;
                    u32x4 w; w.x = cvtpk(v0[0], v0[1]); w.y = cvtpk(v0[2], v0[3]); w.z = cvtpk(v1[0], v1[1]); w.w = cvtpk(v1[2], v1[3]);
                    st16_wt(rowp + bj * HALF, w); }
            }
    }
};
struct EpiProj {
    static constexpr bool KSCALE = false;
    unsigned char* wsb; float sc;
    __device__ __forceinline__ void operator()(const f32x4 (&acc)[2][2][4][2], const Unit& u, LAS unsigned char*, int wr, int wc, int fr, int fq) const {
        bf16* const O = (bf16*)(wsb + WS_PROJ); constexpr int ldc = NPROJ; float* const pst = (float*)(wsb + WS_RSTD); const f32x2* const cs = (const f32x2*)(wsb + WS_ROPE); bf16* const kpe = (bf16*)(wsb + WS_KPE);
        const int row0 = u.pm * BM + wr * 64 + fr, col0 = u.pn * BM + wc * 32 + 8 * fq, lane = fr + 16 * fq;
        float rs8[8];
        if (NORM_FOLD) {
            const float* rp = (const float*)(wsb + WS_RSIN) + row0;
            const int i0_ = 2 * fq, i1_ = 2 * fq + 1;
            const float r0_ = rp[(i0_ >> 2) * HALF + (i0_ & 3) * 16] * sc, r1_ = rp[(i1_ >> 2) * HALF + (i1_ & 3) * 16] * sc;
#pragma unroll
            for (int i = 0; i < 8; ++i) rs8[i] = __builtin_bit_cast(float, __builtin_amdgcn_ds_bpermute((fr + 16 * (i >> 1)) << 2, __builtin_bit_cast(int, (i & 1) ? r1_ : r0_)));
        } else {
#pragma unroll
            for (int i = 0; i < 8; ++i) rs8[i] = sc;
        }
#pragma unroll
        for (int ai = 0; ai < 2; ++ai)
#pragma unroll
            for (int m = 0; m < 4; ++m) {
                const int row = row0 + ai * HALF + m * 16; const float sc = rs8[ai * 4 + m];
                bf16* rowp = O + (size_t)row * ldc + col0;
#pragma unroll
                for (int bj = 0; bj < 2; ++bj) { const f32x4 v0 = acc[ai][bj][m][0] * sc, v1 = acc[ai][bj][m][1] * sc;
                    u32x4 w; w.x = cvtpk(v0[0], v0[1]); w.y = cvtpk(v0[2], v0[3]); w.z = cvtpk(v1[0], v1[1]); w.w = cvtpk(v1[2], v1[3]);
                    st16_wt(rowp + bj * HALF, w); }
                if (u.pn <= 1) {
                    float ss = 0.f;
#pragma unroll
                    for (int bj = 0; bj < 2; ++bj) if (u.pn == 0 || bj == 0) {
#pragma unroll
                        for (int n = 0; n < 2; ++n) { const f32x4 v = acc[ai][bj][m][n] * sc; ss += (v[0] * v[0] + v[1] * v[1]) + (v[2] * v[2] + v[3] * v[3]); } }
                    ss += shx(ss, lane, 16); ss += shx(ss, lane, 32);
                    if (fq == 0) pst[(size_t)row * 8 + 4 * u.pn + wc] = ss;
                    if (u.pn == 1 && wc == 0) {
                        const f32x4 v0 = acc[ai][1][m][0] * sc, v1 = acc[ai][1][m][1] * sc; const f32x2* c4 = cs + (size_t)row * 16 + 4 * fq;
                        const f32x2 c0 = c4[0], c1 = c4[1], c2 = c4[2], c3 = c4[3];
                        u32x4 w; w.x = cvtpk(v0[0] * c0.x - v0[1] * c0.y, v0[1] * c0.x + v0[0] * c0.y); w.y = cvtpk(v0[2] * c1.x - v0[3] * c1.y, v0[3] * c1.x + v0[2] * c1.y);
                        w.z = cvtpk(v1[0] * c2.x - v1[1] * c2.y, v1[1] * c2.x + v1[0] * c2.y); w.w = cvtpk(v1[2] * c3.x - v1[3] * c3.y, v1[3] * c3.x + v1[2] * c3.y);
                        *(u32x4*)(kpe + (size_t)row * 32 + 8 * fq) = w; }
                }
                asm volatile("" ::: "memory");
            }
    }
};
struct EpiQ {
    static constexpr bool KSCALE = false;
    bf16* O; const float* rs; const f32x2* cs;
    struct In { f32x4 p; f32x2 c[2][4]; };
    __device__ __forceinline__ void load(In& in, int row, int i0a, int i0b) const {
        in.p = *(const f32x4*)(rs + (size_t)row * 8);
        const f32x2* ca = cs + (size_t)row * 16 + i0a; const f32x2* cb = cs + (size_t)row * 16 + i0b;
#pragma unroll
        for (int j = 0; j < 4; ++j) { in.c[0][j] = ca[j]; in.c[1][j] = cb[j]; }
    }
    __device__ __forceinline__ void operator()(const f32x4 (&acc)[2][2][4][2], const Unit& u, LAS unsigned char*, int wr, int wc, int fr, int fq) const {
        const int row0 = u.pm * BM + wr * 64 + fr, col0 = u.pn * BM + wc * 32 + 8 * fq;
        const int hd0 = col0 % 96, hd1 = (col0 + HALF) % 96;
        const int i0a = (hd0 >= 64) ? ((hd0 - 64) >> 1) : 0, i0b = (hd1 >= 64) ? ((hd1 - 64) >> 1) : 0;
        In cur, nxt; load(cur, row0, i0a, i0b); nxt = cur;
#pragma unroll
        for (int i = 0; i < 8; ++i) { const int ai = i >> 2, m = i & 3;
            const int row = row0 + ai * HALF + m * 16;
            if (i < 7) load(nxt, row0 + ((i + 1) >> 2) * HALF + ((i + 1) & 3) * 16, i0a, i0b);
            asm volatile("" ::: "memory");
            const float s = rsqrtf(((cur.p[0] + cur.p[1]) + (cur.p[2] + cur.p[3])) * (1.f / 256.f) + RMS_EPS);
            bf16* rowp = O + (size_t)row * 768 + col0;
#pragma unroll
            for (int bj = 0; bj < 2; ++bj) { f32x4 v0 = acc[ai][bj][m][0] * s, v1 = acc[ai][bj][m][1] * s;
                if ((bj ? hd1 : hd0) >= 64) { const f32x2 c0 = cur.c[bj][0], c1 = cur.c[bj][1], c2 = cur.c[bj][2], c3 = cur.c[bj][3];
                    f32x4 a, b;
                    a[0] = v0[0] * c0.x - v0[1] * c0.y; a[1] = v0[1] * c0.x + v0[0] * c0.y; a[2] = v0[2] * c1.x - v0[3] * c1.y; a[3] = v0[3] * c1.x + v0[2] * c1.y;
                    b[0] = v1[0] * c2.x - v1[1] * c2.y; b[1] = v1[1] * c2.x + v1[0] * c2.y; b[2] = v1[2] * c3.x - v1[3] * c3.y; b[3] = v1[3] * c3.x + v1[2] * c3.y;
                    v0 = a; v1 = b; }
                u32x4 w; w.x = cvtpk(v0[0], v0[1]); w.y = cvtpk(v0[2], v0[3]); w.z = cvtpk(v1[0], v1[1]); w.w = cvtpk(v1[2], v1[3]);
                st16_wt(rowp + bj * HALF, w); }
            asm volatile("" ::: "memory");
            cur = nxt;
        }
    }
};
struct EpiResid {
    static constexpr bool KSCALE = false;
    const float* xin32; bf16* r16; float sc;
    __device__ __forceinline__ void operator()(const f32x4 (&acc)[2][2][4][2], const Unit& u, LAS unsigned char*, int wr, int wc, int fr, int fq) const {
        const int row0 = u.pm * BM + wr * 64 + fr, col0 = u.pn * BM + wc * 32 + 8 * fq;
#pragma unroll
        for (int ai = 0; ai < 2; ++ai)
#pragma unroll
            for (int m = 0; m < 4; ++m) {
                const size_t ro = (size_t)(row0 + ai * HALF + m * 16) * DM + col0;
#pragma unroll
                for (int bj = 0; bj < 2; ++bj) {
                    f32x4 x0, x1;
                    if (xin32) { x0 = *(const f32x4*)(xin32 + ro + bj * HALF); x1 = *(const f32x4*)(xin32 + ro + bj * HALF + 4); }
                    else { const u32x4 y = *(const u32x4*)(r16 + ro + bj * HALF); x0 = (f32x4){bf_lo(y.x), bf_hi(y.x), bf_lo(y.y), bf_hi(y.y)}; x1 = (f32x4){bf_lo(y.z), bf_hi(y.z), bf_lo(y.w), bf_hi(y.w)}; }
                    x0 += acc[ai][bj][m][0] * sc; x1 += acc[ai][bj][m][1] * sc;
                    st16_wt(r16 + ro + bj * HALF, (u32x4){cvtpk(x0[0], x0[1]), cvtpk(x0[2], x0[3]), cvtpk(x1[0], x1[1]), cvtpk(x1[2], x1[3])}); }
                asm volatile("" ::: "memory");
            }
    }
};
struct EpiResidNorm {
    static constexpr bool KSCALE = true;
    const float* xin32; bf16* r16; const float* st;
    __device__ __forceinline__ void kfactors(const Unit& u, int wr, int lane_, float (&kf)[2][2][4]) const {
#pragma unroll
        for (int ai = 0; ai < 2; ++ai)
#pragma unroll
            for (int m = 0; m < 4; ++m) { const f32x4* q = (const f32x4*)(st + (size_t)(u.pm * BM + ai * HALF + wr * 64 + m * 16 + (lane_ & 15)) * 16);
                const f32x4 qq = q[lane_ >> 4]; const float sq = (qq[0] + qq[1]) + (qq[2] + qq[3]);
                const int base_ = (lane_ & 15) << 2;
                const float s0 = __builtin_bit_cast(float, __builtin_amdgcn_ds_bpermute(base_, __builtin_bit_cast(int, sq))), s1 = __builtin_bit_cast(float, __builtin_amdgcn_ds_bpermute(base_ + 64, __builtin_bit_cast(int, sq)));
                const float sb = __builtin_bit_cast(float, __builtin_amdgcn_ds_bpermute(base_ + 128, __builtin_bit_cast(int, sq))), sc = __builtin_bit_cast(float, __builtin_amdgcn_ds_bpermute(base_ + 192, __builtin_bit_cast(int, sq)));
                const float sa = s0 + s1;
                const float ra = rsqrtf(sa * (1.f / 512.f) + RMS_EPS), rb = rsqrtf(sb * (1.f / 256.f) + RMS_EPS), rc = rsqrtf(sc * (1.f / 256.f) + RMS_EPS);
                kf[0][ai][m] = ra / rb; kf[1][ai][m] = rb / rc; }
    }
    struct In { f32x4 q3; u32x4 y[2]; f32x4 x[4]; };
    __device__ __forceinline__ void load(In& in, int row, int col0) const { const size_t ro = (size_t)row * DM + col0;
        in.q3 = *(const f32x4*)(st + (size_t)row * 16 + 12);
        if (xin32) { in.x[0] = *(const f32x4*)(xin32 + ro); in.x[1] = *(const f32x4*)(xin32 + ro + 4); in.x[2] = *(const f32x4*)(xin32 + ro + HALF); in.x[3] = *(const f32x4*)(xin32 + ro + HALF + 4); }
        else { in.y[0] = *(const u32x4*)(r16 + ro); in.y[1] = *(const u32x4*)(r16 + ro + HALF); }
    }
    __device__ __forceinline__ void operator()(const f32x4 (&acc)[2][2][4][2], const Unit& u, LAS unsigned char*, int wr, int wc, int fr, int fq) const {
        const int row0 = u.pm * BM + wr * 64 + fr, col0 = u.pn * BM + wc * 32 + 8 * fq;
        In cur, nxt; load(cur, row0, col0); nxt = cur;
#pragma unroll
        for (int i = 0; i < 8; ++i) { const int ai = i >> 2, m = i & 3;
            const int row = row0 + ai * HALF + m * 16; const size_t ro = (size_t)row * DM + col0;
            if (i < 7) load(nxt, row0 + ((i + 1) >> 2) * HALF + ((i + 1) & 3) * 16, col0);
            asm volatile("" ::: "memory");
            const float rc = rsqrtf(((cur.q3[0] + cur.q3[1]) + (cur.q3[2] + cur.q3[3])) * (1.f / 256.f) + RMS_EPS);
#pragma unroll
            for (int bj = 0; bj < 2; ++bj) {
                f32x4 x0, x1;
                if (xin32) { x0 = cur.x[2 * bj]; x1 = cur.x[2 * bj + 1]; }
                else { const u32x4 y = cur.y[bj]; x0 = (f32x4){bf_lo(y.x), bf_hi(y.x), bf_lo(y.y), bf_hi(y.y)}; x1 = (f32x4){bf_lo(y.z), bf_hi(y.z), bf_lo(y.w), bf_hi(y.w)}; }
                x0 += acc[ai][bj][m][0] * rc; x1 += acc[ai][bj][m][1] * rc;
                st16_wt(r16 + ro + bj * HALF, (u32x4){cvtpk(x0[0], x0[1]), cvtpk(x0[2], x0[3]), cvtpk(x1[0], x1[1]), cvtpk(x1[2], x1[3])}); }
            asm volatile("" ::: "memory");
            cur = nxt;
        }
    }
};
struct EpiSwiglu {
    static constexpr bool KSCALE = false;
    unsigned char* O; int NT; float ascale_inv, oscale;
    __device__ __forceinline__ void operator()(const f32x4 (&acc)[2][2][4][2], const Unit& u, LAS unsigned char* sl, int wr, int wc, int fr, int fq) const {
        const int pnl = u.pn - u.e * NT; const int cw = wc * 32 + 8 * fq;
        const LAS float* bs = (const LAS float*)(sl + 2048);
        f32x4 bg[2], bu[2];
#pragma unroll
        for (int n = 0; n < 2; ++n) { bg[n] = *(const LAS f32x4*)(bs + cw + 4 * n); bu[n] = *(const LAS f32x4*)(bs + 128 + cw + 4 * n); }
        unsigned wp0 = 0u, wp1 = 0u;
#pragma unroll
        for (int ai = 0; ai < 2; ++ai)
#pragma unroll
            for (int m = 0; m < 4; ++m) {
                const int rt = ai * HALF + wr * 64 + m * 16 + fr;
                unsigned w[4];
#pragma unroll
                for (int n = 0; n < 2; ++n) { float a[4];
#pragma unroll
                    for (int h2 = 0; h2 < 2; ++h2) {
                        const f32x2 ga = {acc[ai][0][m][n][2 * h2], acc[ai][0][m][n][2 * h2 + 1]}, ua = {acc[ai][1][m][n][2 * h2], acc[ai][1][m][n][2 * h2 + 1]};
                        const f32x2 gb = {bg[n][2 * h2], bg[n][2 * h2 + 1]}, ub = {bu[n][2 * h2], bu[n][2 * h2 + 1]};
                        f32x2 g2 = ga * ascale_inv + gb, u2 = ua * ascale_inv + ub;
                        g2.x = __builtin_amdgcn_fmed3f(g2.x, -25.f, 7.f); g2.y = __builtin_amdgcn_fmed3f(g2.y, -25.f, 7.f); u2.x = __builtin_amdgcn_fmed3f(u2.x, -7.f, 7.f); u2.y = __builtin_amdgcn_fmed3f(u2.y, -7.f, 7.f);
                        const f32x2 t2 = g2 * (-1.702f * LOG2E);
                        f32x2 e2; e2.x = ex2(t2.x); e2.y = ex2(t2.y);
                        const f32x2 d2 = e2 + 1.f;
                        const float rr = __builtin_amdgcn_rcpf(d2.x * d2.y);
                        const f32x2 r2 = (f32x2){d2.y, d2.x} * rr;
                        const f32x2 o2 = (u2 * oscale + oscale) * (g2 * r2);
                        a[2 * h2] = o2.x; a[2 * h2 + 1] = o2.y; }
                    if (DN_FP8) w[n] = pk4_fp8(a[0], a[1], a[2], a[3]); else { w[2 * n] = cvtpk(a[0], a[1]); w[2 * n + 1] = cvtpk(a[2], a[3]); } }
                if (DN_FP8) {
                    if ((m & 1) == 0) { wp0 = w[0]; wp1 = w[1]; }
                    else { const auto r0 = __builtin_amdgcn_permlane16_swap(wp0, w[0], false, false); const auto r1 = __builtin_amdgcn_permlane16_swap(wp1, w[1], false, false);
                        const int rt2 = rt - 16 + 16 * (fq & 1);
                        *(u32x4*)(O + (size_t)(u.pm * 256 + rt2) * 1024 + 128 * pnl + wc * 32 + 8 * (fq & ~1)) = (u32x4){r0[0], r1[0], r0[1], r1[1]}; }
                }
                else *(u32x4*)((bf16*)O + (size_t)(u.pm * 256 + rt) * 1024 + 128 * pnl + cw) = (u32x4){w[0], w[1], w[2], w[3]};
                if (m & 1) asm volatile("" ::: "memory");
            }
    }
};
struct EpiDown {
    static constexpr bool KSCALE = false;
    bf16* YS; int NT; float ascale_inv;
    __device__ __forceinline__ void operator()(const f32x4 (&acc)[2][2][4][2], const Unit& u, LAS unsigned char* sl, int wr, int wc, int fr, int fq) const {
        const int pnl = u.pn - u.e * NT; const int cw = wc * 32 + 8 * fq;
        const LAS int* tk = (const LAS int*)sl; const LAS float* gt = (const LAS float*)(sl + 1024); const LAS float* bs = (const LAS float*)(sl + 2048);
        f32x4 bb[2][2];
#pragma unroll
        for (int bj = 0; bj < 2; ++bj)
#pragma unroll
            for (int n = 0; n < 2; ++n) bb[bj][n] = *(const LAS f32x4*)(bs + bj * HALF + cw + 4 * n);
        if (YS_FP8) {
#pragma unroll
            for (int ai = 0; ai < 2; ++ai)
#pragma unroll
                for (int mp = 0; mp < 2; ++mp) {
                    unsigned d[2][2][2];
#pragma unroll
                    for (int r2 = 0; r2 < 2; ++r2) { const int m = 2 * mp + r2; const int rt = ai * HALF + wr * 64 + m * 16 + fr; const float g = gt[rt];
#pragma unroll
                        for (int bj = 0; bj < 2; ++bj) { const f32x4 v0 = (acc[ai][bj][m][0] * ascale_inv + bb[bj][0]) * g, v1 = (acc[ai][bj][m][1] * ascale_inv + bb[bj][1]) * g;
                            d[r2][bj][0] = pk4_fp8_scaled(v0[0], v0[1], v0[2], v0[3], 1.f / YS_SCALE); d[r2][bj][1] = pk4_fp8_scaled(v1[0], v1[1], v1[2], v1[3], 1.f / YS_SCALE); } }
                    u32x4 ov[2];
#pragma unroll
                    for (int bj = 0; bj < 2; ++bj) { const auto r0 = __builtin_amdgcn_permlane16_swap(d[0][bj][0], d[1][bj][0], false, false); const auto r1 = __builtin_amdgcn_permlane16_swap(d[0][bj][1], d[1][bj][1], false, false);
                        ov[bj] = (u32x4){r0[0], r1[0], r0[1], r1[1]}; }
                    const int rt2 = ai * HALF + wr * 64 + (2 * mp + (fq & 1)) * 16 + fr;
                    if (rt2 < u.nvalid) { const int slot = tk[rt2];
                        unsigned char* rowp8 = (unsigned char*)YS + (size_t)slot * 1024 + 256 * pnl + wc * 32 + 8 * (fq & ~1);
                        *(u32x4*)rowp8 = ov[0]; *(u32x4*)(rowp8 + HALF) = ov[1]; }
                    asm volatile("" ::: "memory");
                }
        } else {
#pragma unroll
        for (int ai = 0; ai < 2; ++ai)
#pragma unroll
            for (int m = 0; m < 4; ++m) {
                const int rt = ai * HALF + wr * 64 + m * 16 + fr;
                if (rt < u.nvalid) {
                    const int slot = tk[rt]; const float g = gt[rt];
                    bf16* rowp = YS + (size_t)slot * 1024 + 256 * pnl + cw; unsigned char* rowp8 = (unsigned char*)YS + (size_t)slot * 1024 + 256 * pnl + cw;
#pragma unroll
                    for (int bj = 0; bj < 2; ++bj) { const f32x4 v0 = (acc[ai][bj][m][0] * ascale_inv + bb[bj][0]) * g, v1 = (acc[ai][bj][m][1] * ascale_inv + bb[bj][1]) * g;
                        if (YS_FP8) { *(u32x2*)(rowp8 + bj * HALF) = (u32x2){pk4_fp8_scaled(v0[0], v0[1], v0[2], v0[3], 1.f / YS_SCALE), pk4_fp8_scaled(v1[0], v1[1], v1[2], v1[3], 1.f / YS_SCALE)}; }
                        else { u32x4 w; w.x = cvtpk(v0[0], v0[1]); w.y = cvtpk(v0[2], v0[3]); w.z = cvtpk(v1[0], v1[1]); w.w = cvtpk(v1[2], v1[3]);
                            st16_wt(rowp + bj * HALF, w); } }
                }
                asm volatile("" ::: "memory");
            }
        }
    }
};
}

__device__ __forceinline__ int crow(int r, int hi) { return (r & 3) + 8 * (r >> 2) + 4 * hi; }
__device__ __forceinline__ bf16x8 pack8(const f32x16& x, int s) {
    u32x4 p; p.x = cvtpk(x[8 * s], x[8 * s + 1]); p.y = cvtpk(x[8 * s + 2], x[8 * s + 3]); p.z = cvtpk(x[8 * s + 4], x[8 * s + 5]); p.w = cvtpk(x[8 * s + 6], x[8 * s + 7]);
    return __builtin_bit_cast(bf16x8, p);
}
__device__ __forceinline__ s16x4 vtr(LAS const unsigned char* p) { return __builtin_bit_cast(s16x4, __builtin_amdgcn_ds_read_tr16_b64_v4i16((LAS v4i16_t*)p)); }

__device__ __forceinline__ void glds16s(const void* sbase, unsigned voff, unsigned ldsdst) { unsigned keep_;
    asm volatile("s_mov_b32 %0, m0\n\ts_mov_b32 m0, %3\n\ts_nop 0\n\tglobal_load_lds_dwordx4 %1, %2 nt\n\ts_mov_b32 m0, %0" : "=&s"(keep_) : "v"(voff), "s"(sbase), "s"(ldsdst) : "memory"); }
struct BgConv {
    const float* wgu; const float* wdn; unsigned char* gu8; unsigned char* dn8;
    unsigned lds_scr; int next, stride, total, pend, tick;
    static constexpr int NGU = NEXP * 16 * 64, NDN = NEXP * 16 * 32;
    __device__ __forceinline__ void locate(int item, const float*& W, unsigned char*& WT, int& N, int& k0, int& n0, bool& gu) const {
        gu = item < NGU;
        if (gu) { const int mi = item >> 10, r = item & 1023; N = 2048; W = wgu + (size_t)mi * 1024 * 2048; WT = gu8 + (size_t)mi * 2048 * 1024; k0 = 64 * (r >> 6); n0 = 32 * (r & 63); }
        else { const int i2 = item - NGU, mi = i2 >> 9, r = i2 & 511; N = 1024; W = wdn + (size_t)mi * 1024 * 1024; WT = dn8 + (size_t)mi * 1024 * 1024; k0 = 64 * (r >> 5); n0 = 32 * (r & 31); }
    }
    __device__ __forceinline__ void issue(int item, int lane) const {
        const float* W; unsigned char* WT; int N, k0, n0; bool gu; locate(item, W, WT, N, k0, n0, gu);
        const float* src = W + (size_t)k0 * N + n0;
        const unsigned voff = (unsigned)(((lane >> 3) * N + 4 * (lane & 7)) * 4);
#pragma unroll
        for (int j = 0; j < 8; ++j) glds16s(src + (size_t)j * 8 * N, voff, lds_scr + (unsigned)j * 1024u);
    }
    __device__ __forceinline__ void convert(int item, int lane, LAS const unsigned char* ldsb) const {
        const float* W; unsigned char* WT; int N, k0, n0; bool gu; locate(item, W, WT, N, k0, n0, gu);
        asm volatile("s_waitcnt vmcnt(0)" ::: "memory");
        const LAS float* scr = (const LAS float*)(ldsb + lds_scr);
        const int n = lane & 31, kh = lane >> 5;
        int row = n0 + n; if (gu) row = (row < 1024) ? 256 * (row >> 7) + (row & 127) : 256 * ((row - 1024) >> 7) + 128 + ((row - 1024) & 127);
        unsigned char* dst = WT + (size_t)row * 1024 + k0 + 16 * kh;
#pragma unroll
        for (int h2 = 0; h2 < 2; ++h2) { float v[16];
#pragma unroll
            for (int i = 0; i < 16; ++i) v[i] = scr[(32 * h2 + 16 * kh + i) * 32 + n];
            *(u32x4*)(dst + 32 * h2) = (u32x4){pk4_fp8_scaled(v[0], v[1], v[2], v[3], 1.f / W_SCALE), pk4_fp8_scaled(v[4], v[5], v[6], v[7], 1.f / W_SCALE), pk4_fp8_scaled(v[8], v[9], v[10], v[11], 1.f / W_SCALE), pk4_fp8_scaled(v[12], v[13], v[14], v[15], 1.f / W_SCALE)}; }
        asm volatile("s_waitcnt lgkmcnt(0)" ::: "memory");
    }
    __device__ __forceinline__ void step(int lane, LAS const unsigned char* ldsb) {
        if (++tick < 3) return;
        tick = 0;
        if (pend >= 0) convert(pend, lane, ldsb);
        if (next < total) { issue(next, lane); pend = next; next += stride; } else pend = -1;
    }
    __device__ __forceinline__ void flush(int lane, LAS const unsigned char* ldsb) {
        if (pend >= 0) { convert(pend, lane, ldsb); pend = -1; }
        for (; next < total; next += stride) { issue(next, lane); convert(next, lane, ldsb); }
    }
};

template <int NQF_> struct AttnPre { bf16x8 qf[NQF_]; u32x4 kr0, kr1, vr; bool valid; };
struct AttnNext { const bf16* qsrc; const bf16* k0src; const bf16* vsrc; int rowbase, qblk; bool has; };
template <int KIND>
__device__ __forceinline__ void attn_prefetch(const int tid, AttnPre<(KIND == 0) ? 6 : 4>& pre, const AttnNext nx, const int qpitch, const int k0pitch, const bf16* __restrict__ k1src, const int vpitch) {
    constexpr int DK = (KIND == 0) ? 96 : 64, KCH = DK / 8, NQF = DK / 16;
    const int lane = tid & 63, w = __builtin_amdgcn_readfirstlane(tid >> 6), r32 = lane & 31, hh = lane >> 5;
    const int vrow = tid >> 3, vc = tid & 7, krow0 = tid / KCH, kc0 = tid % KCH, krow1 = (tid + 512) / KCH, kc1 = (tid + 512) % KCH;
    const bf16* qn = nx.qsrc + (size_t)(nx.rowbase + nx.qblk * 256 + 32 * w + r32) * qpitch;
#pragma unroll
    for (int d0 = 0; d0 < NQF; ++d0) pre.qf[d0] = *(const bf16x8*)(qn + 16 * d0 + 8 * hh);
    const int tn = (KIND == 1) ? (4 * nx.qblk + 3) : (KIND == 2) ? ((4 * nx.qblk - 8) > 0 ? (4 * nx.qblk - 8) : 0) : 0;
    const size_t rb_ = (size_t)nx.rowbase + 64 * (size_t)tn;
    pre.kr1 = (u32x4){0u, 0u, 0u, 0u};
    pre.vr = *(const u32x4*)(nx.vsrc + (rb_ + vrow) * vpitch + 8 * vc);
    if (KIND == 0) { pre.kr0 = (kc0 < 8) ? *(const u32x4*)(nx.k0src + (rb_ + krow0) * k0pitch + 8 * kc0) : *(const u32x4*)(k1src + (rb_ + krow0) * 32 + 8 * (kc0 - 8));
        if (tid < 256) pre.kr1 = (kc1 < 8) ? *(const u32x4*)(nx.k0src + (rb_ + krow1) * k0pitch + 8 * kc1) : *(const u32x4*)(k1src + (rb_ + krow1) * 32 + 8 * (kc1 - 8)); }
    else pre.kr0 = *(const u32x4*)(nx.k0src + (rb_ + krow0) * k0pitch + 8 * kc0);
}
template <int KIND>
__device__ __forceinline__ void attn_unit(const int tid, LAS unsigned char* lds, const bf16* __restrict__ qsrc, const int qpitch,
                                          const bf16* __restrict__ k0src, const int k0pitch, const bf16* __restrict__ k1src,
                                          const bf16* __restrict__ vsrc, const int vpitch, bf16* __restrict__ odst,
                                          const float* __restrict__ relb, const int rowbase, const int qblk, float* __restrict__ mstat  , BgConv& bg,
                                          AttnPre<(KIND == 0) ? 6 : 4>& pre, const AttnNext nx) {
    constexpr int DK = (KIND == 0) ? 96 : 64, KCH = DK / 8, KPITCH = DK * 2 + 16, KBYTES = 64 * KPITCH, NQF = DK / 16;
    constexpr int OFF_K = 0, OFF_V = 2 * KBYTES, OFF_BIAS = OFF_V + 2 * 8192, OFF_DONE = OFF_BIAS + 2064;
    const int lane = tid & 63, w = __builtin_amdgcn_readfirstlane(tid >> 6), r32 = lane & 31, hh = lane >> 5;
    const int c = 4 * qblk + (w >> 1);
    const int tq = 32 * (w & 1) + r32;
    const int T1 = 4 * qblk + 3, T0 = (KIND == 2) ? ((4 * qblk - 8) > 0 ? (4 * qblk - 8) : 0) : 0;
    const int nsteps = T1 - T0 + 1;
#define TILE_OF(it) ((KIND == 1) ? (T1 - (it)) : (T0 + (it)))
    const bf16* qrow = qsrc + (size_t)(rowbase + qblk * 256 + 32 * w + r32) * qpitch;
    bf16x8 qf[NQF];
#pragma unroll
    for (int d0 = 0; d0 < NQF; ++d0) qf[d0] = pre.qf[d0];
    (void)qrow;
    const int vrow = tid >> 3, vc = tid & 7;
    const unsigned vlds = (unsigned)(vrow * 128 + (((vc >> 1) ^ (((vrow >> 1) & 1) << 1)) * 32) + (vc & 1) * 16);
    const int krow0 = tid / KCH, kc0 = tid % KCH;
    const int krow1 = (tid + 512) / KCH, kc1 = (tid + 512) % KCH;
    u32x4 kr0, kr1 = (u32x4){0u, 0u, 0u, 0u}, vr;
#define ATT_ISSUE_X(K0, V, RB, tile, KR0, KR1, VR) do { const size_t rb_ = (size_t)(RB) + 64 * (size_t)(tile); \
        VR = *(const u32x4*)((V) + (rb_ + vrow) * vpitch + 8 * vc); \
        if (KIND == 0) { KR0 = (kc0 < 8) ? *(const u32x4*)((K0) + (rb_ + krow0) * k0pitch + 8 * kc0) : *(const u32x4*)(k1src + (rb_ + krow0) * 32 + 8 * (kc0 - 8)); \
            if (tid < 256) KR1 = (kc1 < 8) ? *(const u32x4*)((K0) + (rb_ + krow1) * k0pitch + 8 * kc1) : *(const u32x4*)(k1src + (rb_ + krow1) * 32 + 8 * (kc1 - 8)); } \
        else { KR0 = *(const u32x4*)((K0) + (rb_ + krow0) * k0pitch + 8 * kc0); } } while (0)
#define ATT_ISSUE(tile) ATT_ISSUE_X(k0src, vsrc, rowbase, tile, kr0, kr1, vr)
#define ATT_WRITE(buf) do { *(LAS u32x4*)(lds + OFF_V + (buf) * 8192 + vlds) = vr; \
        *(LAS u32x4*)(lds + OFF_K + (buf) * KBYTES + krow0 * KPITCH + kc0 * 16) = kr0; \
        if (KIND == 0 && tid < 256) *(LAS u32x4*)(lds + OFF_K + (buf) * KBYTES + krow1 * KPITCH + kc1 * 16) = kr1; } while (0)
    f32x16 o[2]; o[0] = (f32x16){}; o[1] = (f32x16){};
    float l_run = 0.f, R = 0.f;
    f32x16 negm = (f32x16){};
    bool started = false;
    bf16x8 tri0, tri1, ones;
#pragma unroll
    for (int j = 0; j < 8; ++j) { const int k0 = 8 * (j >> 2) + 4 * hh + (j & 3); tri0[j] = (k0 > r32) ? (short)0x3F80 : (short)0; tri1[j] = (16 + k0 > r32) ? (short)0x3F80 : (short)0; ones[j] = (short)0x3F80; }
    constexpr int BT_N = 588, BT_BYTES = BT_N * 4;
    if (KIND == 2) { LAS float* bl = (LAS float*)(lds + OFF_BIAS);
        for (int i = tid; i < 4 * BT_N; i += 512) { const int sidx = i / BT_N, x = i - sidx * BT_N; int j = x - sidx; j = j < 0 ? 0 : (j > 512 ? 512 : j); bl[i] = relb[j] * LOG2E; } }
    const unsigned bias_lane = (unsigned)(OFF_BIAS + ((3 - tq) & 3) * BT_BYTES + 4 * (tq + 256 - 4 * hh - 59 + ((3 - tq) & 3)));
    const int g16 = (lane >> 4) & 1, q4 = (lane & 15) >> 2, p4 = lane & 3;
    const unsigned vb0 = (unsigned)((4 * hh + q4) * 128 + (2 * (0 ^ (q4 >> 1)) + g16) * 32 + 8 * p4);
    const unsigned vb1 = (unsigned)((4 * hh + q4) * 128 + (2 * (1 ^ (q4 >> 1)) + g16) * 32 + 8 * p4);
    LAS int* doneit = (LAS int*)(lds + OFF_DONE);
    bool mydone = false;
    if (KIND == 1 && lane == 0) doneit[w] = 0x7fffffff;
    if (w >= 4) __builtin_amdgcn_s_setprio(1);
    kr0 = pre.kr0; kr1 = pre.kr1; vr = pre.vr;
    ATT_WRITE(0);
    if (nsteps > 1) ATT_ISSUE(TILE_OF(1));
    __syncthreads();
    for (int it = 0; it < nsteps; ++it) {
        const int buf = it & 1, tile = TILE_OF(it);
        if (KIND == 1) { const int dv = doneit[lane & 7]; if (__all(dv < it)) break; }
        const bool active = (tile <= c) && (KIND != 2 || tile >= c - 8) && !mydone;
        if (active) {
            LAS const unsigned char* Kb = lds + OFF_K + buf * KBYTES + r32 * KPITCH + 16 * hh;
            f32x16 p0, p1;
            { bf16x8 ka[NQF], kb2[NQF];
#pragma unroll
              for (int d0 = 0; d0 < NQF; ++d0) { ka[d0] = *(const LAS bf16x8*)(Kb + 32 * d0); kb2[d0] = *(const LAS bf16x8*)(Kb + 32 * KPITCH + 32 * d0); }
              __builtin_amdgcn_sched_barrier(0);
              if (KIND == 1) { p0 = (f32x16){}; p1 = (f32x16){}; p0 = MFMA32(ka[0], qf[0], p0); p1 = MFMA32(kb2[0], qf[0], p1); }
              else { p0 = MFMA32(ka[0], qf[0], negm); p1 = MFMA32(kb2[0], qf[0], negm); }
#pragma unroll
              for (int d0 = 1; d0 < NQF; ++d0) { p0 = MFMA32(ka[d0], qf[d0], p0); p1 = MFMA32(kb2[d0], qf[d0], p1); } }
            if (KIND == 1) {
                const bool diag = (tile == c);
                f32x16 lk0, lk1;
                if (diag) {
#pragma unroll
                    for (int r = 0; r < 16; ++r) {
                        const int kv = crow(r, hh);
                        { const float z = p0[r]; const float t = ex2(fminf(z, 80.f)); float lk = -lg2(1.f + t); if (kv >= tq) lk = 0.f; lk0[r] = lk; p0[r] = z + lk; }
                        { const float z = p1[r]; const float t = ex2(fminf(z, 80.f)); float lk = -lg2(1.f + t); if (kv + 32 >= tq) lk = 0.f; lk1[r] = lk; p1[r] = z + lk; }
                    }
                } else {
#pragma unroll
                    for (int r = 0; r < 16; ++r) {
                        { const float z = p0[r]; const float t = ex2(fminf(z, 80.f)); const float lk = -lg2(1.f + t); lk0[r] = lk; p0[r] = z + lk; }
                        { const float z = p1[r]; const float t = ex2(fminf(z, 80.f)); const float lk = -lg2(1.f + t); lk1[r] = lk; p1[r] = z + lk; }
                    }
                }
                const bf16x8 f0 = pack8(lk0, 0), f1 = pack8(lk0, 1), f2 = pack8(lk1, 0), f3 = pack8(lk1, 1);
                f32x16 rv;
#pragma unroll
                for (int r = 0; r < 16; ++r) rv[r] = R;
                f32x16 y0 = MFMA32(tri0, f0, rv); y0 = MFMA32(tri1, f1, y0); y0 = MFMA32(ones, f2, y0); y0 = MFMA32(ones, f3, y0);
                f32x16 y1 = MFMA32(tri0, f2, rv); y1 = MFMA32(tri1, f3, y1);
                if (diag) {
#pragma unroll
                    for (int r = 0; r < 16; ++r) {
                        const int kv = crow(r, hh);
                        float a0 = ex2(p0[r] + y0[r]), a1 = ex2(p1[r] + y1[r]);
                        if (kv >= tq) a0 = 0.f;
                        if (kv + 32 >= tq) a1 = 0.f;
                        p0[r] = a0; p1[r] = a1;
                    }
                } else {
#pragma unroll
                    for (int r = 0; r < 16; ++r) { p0[r] = ex2(p0[r] + y0[r]); p1[r] = ex2(p1[r] + y1[r]); }
                }
                const float rn = y0[0] + lk0[0];
                R = __builtin_bit_cast(float, __builtin_amdgcn_ds_bpermute(r32 << 2, __builtin_bit_cast(int, rn)));
                if (__all(R < -48.f)) { mydone = true; if (lane == 0) doneit[w] = it; }
            } else {
                if (KIND == 2) {
                    const LAS float* bl = (const LAS float*)(lds + OFF_BIAS);
                    const int dist = c - tile;
                    if (dist >= 5) { const float bc = bl[512];
#pragma unroll
                        for (int r = 0; r < 16; ++r) { p0[r] += bc; p1[r] += bc; } }
                    else { LAS const unsigned char* bp = lds + bias_lane + 256 * dist;
                        f32x4 L[8];
#pragma unroll
                        for (int m = 0; m < 8; ++m) L[m] = *(const LAS f32x4*)(bp + 32 * m);
#pragma unroll
                        for (int r = 0; r < 16; ++r) { const int g = r >> 2, e = r & 3; p0[r] += L[7 - g][3 - e]; p1[r] += L[3 - g][3 - e]; } }
                }
                float mx = p0[0];
#pragma unroll
                for (int r = 0; r < 16; ++r) { mx = fmaxf(mx, p0[r]); mx = fmaxf(mx, p1[r]); }
                mx = fmaxf(mx, shx(mx, lane, 32));
                if (!started || __any(mx > 8.f)) {
                    const float delta = started ? fmaxf(mx, 0.f) : mx;
                    if (started) { const float alpha = ex2(-delta); l_run *= alpha; o[0] *= alpha; o[1] *= alpha; }
                    const float nm = negm[0] - delta;
#pragma unroll
                    for (int r = 0; r < 16; ++r) { negm[r] = nm; p0[r] -= delta; p1[r] -= delta; }
                    started = true;
                }
                float sum = 0.f;
#pragma unroll
                for (int r = 0; r < 16; ++r) { p0[r] = ex2(p0[r]); p1[r] = ex2(p1[r]); sum += p0[r] + p1[r]; }
                l_run += sum;
            }
            const bf16x8 pb0 = pack8(p0, 0), pb1 = pack8(p0, 1), pb2 = pack8(p1, 0), pb3 = pack8(p1, 1);
            LAS const unsigned char* Vb = lds + OFF_V + buf * 8192;
#pragma unroll
            for (int d0 = 0; d0 < 2; ++d0) {
                LAS const unsigned char* vp = Vb + (d0 ? vb1 : vb0);
                bf16x8 vf[4];
#pragma unroll
                for (int ks = 0; ks < 4; ++ks) {
                    const s16x4 lo = vtr(vp + (16 * ks) * 128), hi = vtr(vp + (16 * ks + 8) * 128);
                    vf[ks] = __builtin_shufflevector(lo, hi, 0, 1, 2, 3, 4, 5, 6, 7); }
                __builtin_amdgcn_sched_barrier(0);
#pragma unroll
                for (int ks = 0; ks < 4; ++ks) o[d0] = MFMA32(vf[ks], (ks == 0 ? pb0 : ks == 1 ? pb1 : ks == 2 ? pb2 : pb3), o[d0]);
            }
        }
        if (it + 1 < nsteps) ATT_WRITE(buf ^ 1);
        if (BG_CONV) bg.step(lane, lds);
        if (it + 2 < nsteps) ATT_ISSUE(TILE_OF(it + 2));
        asm volatile("s_waitcnt lgkmcnt(0)" ::: "memory");
        __builtin_amdgcn_s_barrier();
        asm volatile("" ::: "memory");
    }
    if (KIND == 1) { asm volatile("s_waitcnt lgkmcnt(0)" ::: "memory"); __builtin_amdgcn_s_barrier(); asm volatile("" ::: "memory"); }
    __builtin_amdgcn_s_setprio(0);
    if (nx.has) attn_prefetch<KIND>(tid, pre, nx, qpitch, k0pitch, k1src, vpitch);
    float inv = 1.f;
    if (KIND != 1) { const float lt = l_run + shx(l_run, lane, 32); inv = 1.f / lt; }
    LAS unsigned char* st = lds + (w < 4 ? 45056 + w * 4608 : 131072 + (w - 4) * 4608);
#pragma unroll
    for (int d0 = 0; d0 < 2; ++d0)
#pragma unroll
        for (int g = 0; g < 4; ++g) {
            u32x2 v; v.x = cvtpk(o[d0][4 * g] * inv, o[d0][4 * g + 1] * inv); v.y = cvtpk(o[d0][4 * g + 2] * inv, o[d0][4 * g + 3] * inv);
            *(LAS u32x2*)(st + r32 * 144 + (32 * d0 + 8 * g + 4 * hh) * 2) = v;
        }
    { bf16* ob = odst + (size_t)(rowbase + qblk * 256 + 32 * w + (lane >> 3)) * DM + 8 * (lane & 7);
      LAS const unsigned char* sr = st + (lane >> 3) * 144 + (lane & 7) * 16;
#pragma unroll
      for (int i = 0; i < 4; ++i) { const u32x4 t = *(LAS const u32x4*)(sr + i * 8 * 144); st16_wt(ob + (size_t)i * 8 * DM, t); } }
    if (mstat) { float ss = 0.f;
#pragma unroll
        for (int d0 = 0; d0 < 2; ++d0)
#pragma unroll
            for (int r = 0; r < 16; ++r) { const float t = o[d0][r] * inv; ss += t * t; }
        ss += shx(ss, lane, 32);
        if (hh == 0) mstat[(size_t)(rowbase + qblk * 256 + 32 * w + r32) * 16] = ss; }
#undef TILE_OF
#undef ATT_ISSUE
#undef ATT_ISSUE_X
#undef ATT_WRITE
}

struct MapIdent { __device__ __forceinline__ int row(int n) const { return n; } __device__ __forceinline__ float ns(int) const { return 1.f; } __device__ __forceinline__ float kg(int) const { return 1.f; } };
struct MapKG { const float* g; __device__ __forceinline__ int row(int n) const { return n; } __device__ __forceinline__ float ns(int) const { return 1.f; } __device__ __forceinline__ float kg(int k) const { return g[k]; } };
struct MapWin {
    __device__ __forceinline__ int row(int n) const { if (n < 384) return n; if (n < 416) { const int j = n - 384; return (j < 16) ? 384 + 2 * j : 384 + 2 * (j - 16) + 1; } return n + 96; }
    __device__ __forceinline__ float ns(int n) const { return ((n >= 416 && n < 672) || (n >= 1184 && n < 1440)) ? 0.125f * LOG2E : 1.f; }
    __device__ __forceinline__ float kg(int) const { return 1.f; }
};
struct MapWinG { const float* g;
    __device__ __forceinline__ int row(int n) const { return MapWin{}.row(n); }
    __device__ __forceinline__ float ns(int n) const { return MapWin{}.ns(n); }
    __device__ __forceinline__ float kg(int k) const { return g[k]; }
};
struct MapWuq { const float* g;
    __device__ __forceinline__ int row(int n) const { const int h = n / 96, d = n % 96; if (d < 64) return n; const int j = d - 64; return 96 * h + 64 + ((j < 16) ? 2 * j : 2 * (j - 16) + 1); }
    __device__ __forceinline__ float ns(int) const { return 0.10206207261596575f * LOG2E; }
    __device__ __forceinline__ float kg(int k) const { return g[k]; }
};
struct MapWgu {
    __device__ __forceinline__ int row(int n) const { if (n < 1024) return 256 * (n >> 7) + (n & 127); const int n2 = n - 1024; return 256 * (n2 >> 7) + 128 + (n2 & 127); }
    __device__ __forceinline__ float ns(int) const { return 1.f; } __device__ __forceinline__ float kg(int) const { return 1.f; }
};
template <class Map>
__device__ __forceinline__ void cvt_item(const float* __restrict__ W, const int K, const int N, bf16* __restrict__ WT, LAS float* scr, const int item, const int lane, const Map mp) {
    const int nblk = N / 32, kb = item / nblk, nb = item % nblk, k0 = 64 * kb, n0 = 32 * nb;
    float rr[32];
#pragma unroll
    for (int i = 0; i < 32; ++i) { const int kk = 2 * i + (lane >> 5); rr[i] = __builtin_nontemporal_load(W + (size_t)(k0 + kk) * N + n0 + (lane & 31)); }
#pragma unroll
    for (int i = 0; i < 32; ++i) { const int kk = 2 * i + (lane >> 5); scr[kk * 33 + (lane & 31)] = rr[i] * mp.kg(k0 + kk); }
    LDS_WAIT(); asm volatile("" ::: "memory");
    const int cc = lane & 7;
#pragma unroll
    for (int j = 0; j < 4; ++j) { const int n = (lane >> 3) + 8 * j; const LAS float* s = scr + (8 * cc) * 33 + n; const float sc = mp.ns(n0 + n);
        u32x4 o; o.x = cvtpk(s[0 * 33] * sc, s[1 * 33] * sc); o.y = cvtpk(s[2 * 33] * sc, s[3 * 33] * sc); o.z = cvtpk(s[4 * 33] * sc, s[5 * 33] * sc); o.w = cvtpk(s[6 * 33] * sc, s[7 * 33] * sc);
        *(u32x4*)(WT + (size_t)mp.row(n0 + n) * K + k0 + 8 * cc) = o; }
    LDS_WAIT(); asm volatile("" ::: "memory");
}

template <class Map>
__device__ __forceinline__ void cvt_item_fp8(const float* __restrict__ W, const int K, const int N, unsigned char* __restrict__ WT, LAS float* scr, const int item, const int lane, const Map mp, const float scale) {
    const int nblk = N / 32, kb = item / nblk, nb = item % nblk, k0 = 64 * kb, n0 = 32 * nb;
    float rr[32];
#pragma unroll
    for (int i = 0; i < 32; ++i) { const int kk = 2 * i + (lane >> 5); rr[i] = __builtin_nontemporal_load(W + (size_t)(k0 + kk) * N + n0 + (lane & 31)); }
#pragma unroll
    for (int i = 0; i < 32; ++i) { const int kk = 2 * i + (lane >> 5); scr[kk * 33 + (lane & 31)] = rr[i] * scale; }
    LDS_WAIT(); asm volatile("" ::: "memory");
    const int cc = lane & 7;
#pragma unroll
    for (int j = 0; j < 4; ++j) { const int n = (lane >> 3) + 8 * j; const LAS float* s = scr + (8 * cc) * 33 + n;
        const float sc = mp.ns(n0 + n);
        u32x2 o; o.x = pk4_fp8_sat(s[0 * 33] * sc, s[1 * 33] * sc, s[2 * 33] * sc, s[3 * 33] * sc); o.y = pk4_fp8_sat(s[4 * 33] * sc, s[5 * 33] * sc, s[6 * 33] * sc, s[7 * 33] * sc);
        *(u32x2*)(WT + (size_t)mp.row(n0 + n) * K + k0 + 8 * cc) = o; }
    LDS_WAIT(); asm volatile("" ::: "memory");
}

template <class Map>
__device__ __forceinline__ void cvt_item_fp8_k128(const float* __restrict__ W, const int K, const int N, unsigned char* __restrict__ WT, LAS float* scr, const int item, const int lane, const Map mp, const float scale) {
    const int nblk = N / 32, kb = item / nblk, nb = item % nblk, k0 = 128 * kb, n0 = 32 * nb;
#pragma unroll
    for (int hf = 0; hf < 2; ++hf) {
        float rr[32];
#pragma unroll
        for (int i = 0; i < 32; ++i) { const int kk = 64 * hf + 2 * i + (lane >> 5); rr[i] = __builtin_nontemporal_load(W + (size_t)(k0 + kk) * N + n0 + (lane & 31)); }
#pragma unroll
        for (int i = 0; i < 32; ++i) { const int kk = 64 * hf + 2 * i + (lane >> 5); scr[kk * 33 + (lane & 31)] = rr[i] * scale; }
    }
    LDS_WAIT(); asm volatile("" ::: "memory");
    const int cc = lane & 7;
#pragma unroll
    for (int j = 0; j < 4; ++j) { const int n = (lane >> 3) + 8 * j; const LAS float* s = scr + (16 * cc) * 33 + n; const float sc = mp.ns(n0 + n);
        u32x4 o;
        o.x = pk4_fp8_sat(s[0 * 33] * sc, s[1 * 33] * sc, s[2 * 33] * sc, s[3 * 33] * sc); o.y = pk4_fp8_sat(s[4 * 33] * sc, s[5 * 33] * sc, s[6 * 33] * sc, s[7 * 33] * sc);
        o.z = pk4_fp8_sat(s[8 * 33] * sc, s[9 * 33] * sc, s[10 * 33] * sc, s[11 * 33] * sc); o.w = pk4_fp8_sat(s[12 * 33] * sc, s[13 * 33] * sc, s[14 * 33] * sc, s[15 * 33] * sc);
        *(u32x4*)(WT + (size_t)mp.row(n0 + n) * K + k0 + 16 * cc) = o; }
    LDS_WAIT(); asm volatile("" ::: "memory");
}

__device__ __forceinline__ void norm_store_bf16(const f32x4 (&v)[4], const float rstd, const float* __restrict__ g, bf16* __restrict__ orow, const int lane) {
#pragma unroll
    for (int j = 0; j < 2; ++j) { const f32x4 g0 = *(const f32x4*)(g + 8 * lane + 512 * j), g1 = *(const f32x4*)(g + 8 * lane + 512 * j + 4);
        const f32x4 a = v[2 * j] * rstd * g0, b = v[2 * j + 1] * rstd * g1;
        u32x4 w; w.x = cvtpk(a[0], a[1]); w.y = cvtpk(a[2], a[3]); w.z = cvtpk(b[0], b[1]); w.w = cvtpk(b[2], b[3]);
        *(u32x4*)(orow + 8 * lane + 512 * j) = w; }
}
__device__ __forceinline__ void norm_store_fp8(const f32x4 (&v)[4], const float rstd, const float* __restrict__ g, unsigned char* __restrict__ orow, const int lane, const float sc) {
#pragma unroll
    for (int j = 0; j < 2; ++j) { const f32x4 g0 = *(const f32x4*)(g + 8 * lane + 512 * j), g1 = *(const f32x4*)(g + 8 * lane + 512 * j + 4);
        const f32x4 a = v[2 * j] * (rstd * sc) * g0, b = v[2 * j + 1] * (rstd * sc) * g1;
        *(u32x2*)(orow + 8 * lane + 512 * j) = (u32x2){pk4_fp8(a[0], a[1], a[2], a[3]), pk4_fp8(b[0], b[1], b[2], b[3])}; }
}
__device__ __forceinline__ float sumsq4(const f32x4 (&v)[4]) {
    float s = 0.f;
#pragma unroll
    for (int j = 0; j < 4; ++j) s += (v[j][0] * v[j][0] + v[j][1] * v[j][1]) + (v[j][2] * v[j][2] + v[j][3] * v[j][3]);
    return s;
}

struct Args { const float* in[19]; float* out; unsigned char* ws; };


typedef const __attribute__((address_space(4))) struct Args* CArgsP;
#define PH_BEGIN CArgsP ap_; { unsigned long long kp_ = (unsigned long long)__builtin_amdgcn_kernarg_segment_ptr(); asm volatile("" : "+s"(kp_)); ap_ = (CArgsP)kp_; } unsigned char* const ws = ap_->ws; \
    int w_ = bar.w, bx_ = (int)blockIdx.x; asm volatile("" : "+s"(w_), "+s"(bx_)); int tid_ = (w_ << 6) | lane_id(); asm volatile("" : "+v"(tid_)); \
    const int tid = tid_, bx = bx_, lane = tid & 63, wave = __builtin_amdgcn_readfirstlane(tid >> 6), G = (int)gridDim.x; \
    const int vcu = (G % 8 == 0) ? (bx % 8) * (G / 8) + bx / 8 : bx; const int gw = vcu * NWAVES + wave, NGW = G * NWAVES; (void)lane; (void)gw; (void)NGW
#define ctl ((unsigned*)(ws + WS_CTL))
#define x_in (ap_->in[0])
#define positions ((const int*)ap_->in[1])
#define attn_norm (ap_->in[2])
#define w_in (ap_->in[3])
#define q_norm (ap_->in[4])
#define w_uq (ap_->in[5])
#define kv_norm (ap_->in[6])
#define w_ukv (ap_->in[7])
#define rel_bias (ap_->in[8])
#define mix_norm (ap_->in[9])
#define w_o (ap_->in[10])
#define ffn_norm (ap_->in[11])
#define w_router (ap_->in[12])
#define b_router (ap_->in[13])
#define w_gu (ap_->in[14])
#define b_gu (ap_->in[15])
#define w_dn (ap_->in[16])
#define b_dn (ap_->in[17])
#define final_norm (ap_->in[18])
#define Rres (ap_->out)
#define R16 ((bf16*)(ws + WS_R16))
#define MSTAT ((float*)(ws + WS_MSTAT))
#define WinT ((bf16*)(ws + WS_WIN))
#define WuqT ((bf16*)(ws + WS_WUQ))
#define WukvT ((bf16*)(ws + WS_WUKV))
#define WoT ((bf16*)(ws + WS_WO))
#define WguT ((unsigned char*)(ws + WS_WGU))
#define WdnT ((unsigned char*)(ws + WS_WDN))
#define H8 ((unsigned char*)(ws + WS_H8))
#define ropecs ((f32x2*)(ws + WS_ROPE))
#define rstd ((float*)(ws + WS_RSTD))
#define kpe_r ((bf16*)(ws + WS_KPE))
#define tok_of ((int*)(ws + WS_TOK))
#define gate_of ((float*)(ws + WS_GATE))
#define Hb ((bf16*)(ws + WS_H))
#define PROJ ((bf16*)(ws + WS_PROJ))
#define QB ((bf16*)(ws + WS_QB))
#define KVB ((bf16*)(ws + WS_KVB))
#define MIXED ((bf16*)(ws + WS_MIXED))
#define ACT ((unsigned char*)(ws + WS_ACT))
#define YS ((bf16*)(ws + WS_YS))
#ifndef REP_MASK
#define REP_MASK 0
#endif
#define NREP(k) (((REP_MASK >> (k)) & 1) ? 2 : 1)
#define IN(k) (((KMASK >> (k)) & 1) != 0)
#define SEAM(k) do { if (MULTI) xcd_barrier(bar); } while (0)
template <int KMASK, int l>
__device__ __forceinline__ void layer_body(LAS unsigned char* lds, const XcdBarrier& bar) {
    constexpr bool MULTI = (KMASK & (KMASK - 1)) != 0;
        constexpr int pb = 0;
        if (IN(pb + 0)) for (int rep_ = 0; rep_ < NREP(0); ++rep_) {
            PH_BEGIN;
            pg8::DenseSched S; S.init(NTOK, NPROJ, G, bx, DG_FP8 ? DM : DM * 2, 0);
            pg8::EpiStore E{PROJ, NPROJ, nullptr, 0, DG_FP8 ? 1.f / (H_SCALE * W_SCALE) : 1.f};
            if (DG_FP8) pg8::gemm_phase<pg8::EpiStore, pg8::DenseSched, true>(tid, lds, H8, (unsigned char*)WinT + (size_t)l * NPROJ * 1024, 1024, S, E);
            else if (PREP_FUSED) { pg8::EpiProj EP{ws, 1.f}; pg8::gemm_phase(tid, lds, NORM_FOLD ? R16 : Hb, WinT + (size_t)l * NPROJ * 1024, 2048, S, EP); }
            else pg8::gemm_phase(tid, lds, Hb, WinT + (size_t)l * NPROJ * 1024, 2048, S, E);
        }
        SEAM(pb + 0);
        if (IN(pb + 1) && !PREP_FUSED) for (int rep_ = 0; rep_ < NREP(1); ++rep_) {
            PH_BEGIN;
            for (int row = gw; row < NTOK; row += NGW) {
                const bf16* pr = PROJ + (size_t)row * NPROJ;
                u32x4 v = (u32x4){0u, 0u, 0u, 0u};
                if (lane < 52) v = *(const u32x4*)(pr + 8 * lane);
                float e[8]; e[0] = bf_lo(v.x); e[1] = bf_hi(v.x); e[2] = bf_lo(v.y); e[3] = bf_hi(v.y); e[4] = bf_lo(v.z); e[5] = bf_hi(v.z); e[6] = bf_lo(v.w); e[7] = bf_hi(v.w);
                float ss = 0.f;
#pragma unroll
                for (int j = 0; j < 8; ++j) ss += e[j] * e[j];
                const float sq = wave_sum(lane < 32 ? ss : 0.f, lane), skv = wave_sum((lane >= 32 && lane < 48) ? ss : 0.f, lane);
                if (lane == 0) { rstd[row * 2 + 0] = rsqrtf(sq * (1.f / 256.f) + RMS_EPS); rstd[row * 2 + 1] = rsqrtf(skv * (1.f / 128.f) + RMS_EPS); }
                if (lane >= 48 && lane < 52) { const int i0 = 4 * (lane - 48); const f32x2* cs = ropecs + (size_t)row * 16 + i0; u32x4 w;
                    { const f32x2 c0 = cs[0]; w.x = cvtpk(e[0] * c0.x - e[1] * c0.y, e[1] * c0.x + e[0] * c0.y); }
                    { const f32x2 c0 = cs[1]; w.y = cvtpk(e[2] * c0.x - e[3] * c0.y, e[3] * c0.x + e[2] * c0.y); }
                    { const f32x2 c0 = cs[2]; w.z = cvtpk(e[4] * c0.x - e[5] * c0.y, e[5] * c0.x + e[4] * c0.y); }
                    { const f32x2 c0 = cs[3]; w.w = cvtpk(e[6] * c0.x - e[7] * c0.y, e[7] * c0.x + e[6] * c0.y); }
                    *(u32x4*)(kpe_r + (size_t)row * 32 + 8 * (lane - 48)) = w; }
            }
        }
        if (!PREP_FUSED) SEAM(pb + 1);
        if (IN(pb + 2)) for (int rep_ = 0; rep_ < NREP(2); ++rep_) {
            PH_BEGIN;
            { pg8::DenseSched S; S.init(NTOK, 768, G, bx, NPROJ * 2, PC_CQ * 2);
              pg8::EpiQ E{QB, rstd, ropecs};
              int kq = 512; asm volatile("" : "+s"(kq));
              pg8::gemm_phase(tid, lds, PROJ, WuqT + (size_t)l * 768 * 256, kq, S, E); }
            { pg8::DenseSched S; S.init(NTOK, 1024, G, bx, NPROJ * 2, PC_CKV * 2); if (G == 256) S.deal = 1;
              pg8::EpiStore E{KVB, 1024, rstd, 1, 1.f};
              int kk = 256; asm volatile("" : "+s"(kk));
              pg8::gemm_phase(tid, lds, PROJ, WukvT + (size_t)l * 1024 * 128, kk, S, E); }
        }
        SEAM(pb + 2);
        if (IN(pb + 3)) for (int rep_ = 0; rep_ < NREP(3); ++rep_) {
            PH_BEGIN;
            BgConv bg; bg.wgu = w_gu + (size_t)l * NEXP * 1024 * 2048; bg.wdn = w_dn + (size_t)l * NEXP * 1024 * 1024; bg.gu8 = WguT + (size_t)l * NEXP * 2048 * 1024; bg.dn8 = WdnT + (size_t)l * NEXP * 1024 * 1024;
            bg.lds_scr = 65536u + (unsigned)wave * 8192u; bg.next = gw; bg.stride = NGW; bg.total = BG_CONV ? (BgConv::NGU + BgConv::NDN) : 0; bg.pend = -1; bg.tick = 0;
#define ATT_CC(itx) int cc = (itx) & 255; cc = (cc % 8) * 32 + cc / 8
#define MLA_UNIT(itx_, b_, h_, qb_) const int r_##b_ = (itx_) >> 8; int c_##b_ = (itx_) & 255; c_##b_ = (c_##b_ % 8) * 32 + c_##b_ / 8; const int b_ = c_##b_ >> 4, h_ = (c_##b_ >> 1) & 7; \
                const int qb_ = (c_##b_ & 1) ? ((r_##b_ == 0) ? 1 : (r_##b_ == 1) ? 6 : (r_##b_ == 2) ? 3 : 4) : ((r_##b_ == 0) ? 0 : (r_##b_ == 1) ? 7 : (r_##b_ == 2) ? 2 : 5)
            for (int rk_ = 0; rk_ < NREP(11); ++rk_) { int t0 = (wave << 6) | lane_id(); asm volatile("" : "+v"(t0)); AttnPre<6> pre0; pre0.valid = true;
              { MLA_UNIT(bx, bp, hp, qbp); AttnNext n0; n0.has = true; n0.qsrc = QB + 96 * hp; n0.k0src = KVB + 128 * hp; n0.vsrc = KVB + 128 * hp + 64; n0.rowbase = bp * SEQ; n0.qblk = qbp; attn_prefetch<0>(t0, pre0, n0, 768, 1024, kpe_r, 1024); }
              for (int itx = bx; itx < 1024; itx += G) { MLA_UNIT(itx, b, h, qb); MLA_UNIT(itx + G, bn, hn, qbn);
                AttnNext nx; nx.has = (itx + G) < 1024; nx.qsrc = QB + 96 * hn; nx.k0src = KVB + 128 * hn; nx.vsrc = KVB + 128 * hn + 64; nx.rowbase = bn * SEQ; nx.qblk = qbn;
                attn_unit<0>(t0, lds, QB + 96 * h, 768, KVB + 128 * h, 1024, kpe_r, KVB + 128 * h + 64, 1024, MIXED + 64 * h, nullptr, b * SEQ, qb, MIX_FUSED ? MSTAT + (size_t)l * NTOK * 16 + h : nullptr, bg, pre0, nx); } }
#undef MLA_UNIT
#define SB_UNIT(itx_, b_, h_, qb_) const int r_##b_ = (itx_) >> 8; int c_##b_ = (itx_) & 255; c_##b_ = (c_##b_ % 8) * 32 + c_##b_ / 8; const int b_ = c_##b_ >> 4, h_ = (c_##b_ >> 2) & 3; \
                const int qb_ = (r_##b_ == 4) ? (c_##b_ & 3) : 7 - (c_##b_ & 3)
            for (int rk_ = 0; rk_ < NREP(12); ++rk_) { int t1 = (wave << 6) | lane_id(); asm volatile("" : "+v"(t1)); AttnPre<4> pre1; pre1.valid = true;
              { SB_UNIT(1024 + bx, bp, hp, qbp); AttnNext n0; n0.has = true; n0.qsrc = PROJ + PC_SBQ + 64 * hp; n0.k0src = PROJ + PC_SBK + 64 * hp; n0.vsrc = PROJ + PC_SBV + 64 * hp; n0.rowbase = bp * SEQ; n0.qblk = qbp; attn_prefetch<1>(t1, pre1, n0, NPROJ, NPROJ, nullptr, NPROJ); }
              for (int itx = 1024 + bx; itx < 1536; itx += G) { SB_UNIT(itx, b, h, qb); SB_UNIT(itx + G, bn, hn, qbn);
                AttnNext nx; nx.has = (itx + G) < 1536; nx.qsrc = PROJ + PC_SBQ + 64 * hn; nx.k0src = PROJ + PC_SBK + 64 * hn; nx.vsrc = PROJ + PC_SBV + 64 * hn; nx.rowbase = bn * SEQ; nx.qblk = qbn;
                attn_unit<1>(t1, lds, PROJ + PC_SBQ + 64 * h, NPROJ, PROJ + PC_SBK + 64 * h, NPROJ, nullptr, PROJ + PC_SBV + 64 * h, NPROJ, MIXED + 512 + 64 * h, nullptr, b * SEQ, qb, MIX_FUSED ? MSTAT + (size_t)l * NTOK * 16 + 8 + h : nullptr, bg, pre1, nx); } }
#undef SB_UNIT
#define CA_UNIT(itx_, b_, h_, qb_) const int r_##b_ = (itx_) >> 8; int c_##b_ = (itx_) & 255; c_##b_ = (c_##b_ % 8) * 32 + c_##b_ / 8; const int b_ = c_##b_ >> 4, h_ = (c_##b_ >> 2) & 3; \
                const int qb_ = 2 * (c_##b_ & 3) + (r_##b_ - 6)
            for (int rk_ = 0; rk_ < NREP(13); ++rk_) { int t2 = (wave << 6) | lane_id(); asm volatile("" : "+v"(t2)); AttnPre<4> pre2; pre2.valid = true;
              { CA_UNIT(1536 + bx, bp, hp, qbp); AttnNext n0; n0.has = true; n0.qsrc = PROJ + PC_CAQ + 64 * hp; n0.k0src = PROJ + PC_CAK + 64 * hp; n0.vsrc = PROJ + PC_CAV + 64 * hp; n0.rowbase = bp * SEQ; n0.qblk = qbp; attn_prefetch<2>(t2, pre2, n0, NPROJ, NPROJ, nullptr, NPROJ); }
              for (int itx = 1536 + bx; itx < 2048; itx += G) { CA_UNIT(itx, b, h, qb); CA_UNIT(itx + G, bn, hn, qbn);
                AttnNext nx; nx.has = (itx + G) < 2048; nx.qsrc = PROJ + PC_CAQ + 64 * hn; nx.k0src = PROJ + PC_CAK + 64 * hn; nx.vsrc = PROJ + PC_CAV + 64 * hn; nx.rowbase = bn * SEQ; nx.qblk = qbn;
                attn_unit<2>(t2, lds, PROJ + PC_CAQ + 64 * h, NPROJ, PROJ + PC_CAK + 64 * h, NPROJ, nullptr, PROJ + PC_CAV + 64 * h, NPROJ, MIXED + 768 + 64 * h, rel_bias + ((size_t)l * 4 + h) * 513, b * SEQ, qb, MIX_FUSED ? MSTAT + (size_t)l * NTOK * 16 + 12 + h : nullptr, bg, pre2, nx); } }
#undef CA_UNIT
#undef ATT_CC
            if (BG_CONV) bg.flush(lane_id(), lds);
        }
        SEAM(pb + 3);
        if (IN(pb + 4) && !MIX_FUSED) for (int rep_ = 0; rep_ < NREP(4); ++rep_) {
            PH_BEGIN;
            const float* g = mix_norm + (size_t)l * DM;
            for (int row = gw; row < NTOK; row += NGW) {
                bf16* mr = MIXED + (size_t)row * DM + 16 * lane;
                const u32x4 a = *(const u32x4*)mr, b = *(const u32x4*)(mr + 8);
                float e[16]; e[0] = bf_lo(a.x); e[1] = bf_hi(a.x); e[2] = bf_lo(a.y); e[3] = bf_hi(a.y); e[4] = bf_lo(a.z); e[5] = bf_hi(a.z); e[6] = bf_lo(a.w); e[7] = bf_hi(a.w);
                e[8] = bf_lo(b.x); e[9] = bf_hi(b.x); e[10] = bf_lo(b.y); e[11] = bf_hi(b.y); e[12] = bf_lo(b.z); e[13] = bf_hi(b.z); e[14] = bf_lo(b.w); e[15] = bf_hi(b.w);
                float ss = 0.f;
#pragma unroll
                for (int j = 0; j < 16; ++j) ss += e[j] * e[j];
                const float sa = wave_sum(lane < 32 ? ss : 0.f, lane), sb = wave_sum((lane >= 32 && lane < 48) ? ss : 0.f, lane), sc = wave_sum(lane >= 48 ? ss : 0.f, lane);
                const float rs = (lane < 32) ? rsqrtf(sa * (1.f / 512.f) + RMS_EPS) : (lane < 48) ? rsqrtf(sb * (1.f / 256.f) + RMS_EPS) : rsqrtf(sc * (1.f / 256.f) + RMS_EPS);
                const float* gp = g + 16 * lane; unsigned w[8];
#pragma unroll
                for (int j = 0; j < 8; ++j) w[j] = cvtpk(e[2 * j] * rs * gp[2 * j], e[2 * j + 1] * rs * gp[2 * j + 1]);
                if (DG_FP8) { unsigned q[4];
#pragma unroll
                    for (int j = 0; j < 4; ++j) q[j] = pk4_fp8(e[4 * j] * rs * gp[4 * j] * H_SCALE, e[4 * j + 1] * rs * gp[4 * j + 1] * H_SCALE, e[4 * j + 2] * rs * gp[4 * j + 2] * H_SCALE, e[4 * j + 3] * rs * gp[4 * j + 3] * H_SCALE);
                    *(u32x4*)(H8 + (size_t)row * DM + 16 * lane) = (u32x4){q[0], q[1], q[2], q[3]}; }
                else { *(u32x4*)mr = (u32x4){w[0], w[1], w[2], w[3]}; *(u32x4*)(mr + 8) = (u32x4){w[4], w[5], w[6], w[7]}; }
            }
        }
        if (!MIX_FUSED) SEAM(pb + 4);
        if (IN(pb + 5)) for (int rep_ = 0; rep_ < NREP(5); ++rep_) {
            PH_BEGIN;
            pg8::DenseSched S; S.init(NTOK, DM, G, bx, DG_FP8 ? DM : DM * 2, 0);
            pg8::EpiResid E{(l == 0) ? x_in : (const float*)nullptr, R16, DG_FP8 ? 1.f / (H_SCALE * W_SCALE) : 1.f};
            if (DG_FP8) pg8::gemm_phase<pg8::EpiResid, pg8::DenseSched, true>(tid, lds, H8, (unsigned char*)WoT + (size_t)l * 1024 * 1024, 1024, S, E);
            else if (MIX_FUSED) { pg8::EpiResidNorm EN{(l == 0 && !NORM_FOLD) ? x_in : (const float*)nullptr, R16, MSTAT + (size_t)l * NTOK * 16};
                pg8::gemm_phase(tid, lds, MIXED, WoT + (size_t)l * 1024 * 1024, 2048, S, EN); }
            else pg8::gemm_phase(tid, lds, MIXED, WoT + (size_t)l * 1024 * 1024, 2048, S, E);
        }
        SEAM(pb + 5);
        if (IN(pb + 6)) for (int rep_ = 0; rep_ < NREP(6); ++rep_) {
            PH_BEGIN;
            LAS int* lcnt = (LAS int*)(lds + LDS_MISC); LAS int* lbase = (LAS int*)(lds + LDS_MISC + 128);
            constexpr int NENT = 1024;
            LAS int* ent_e = (LAS int*)(lds + LDS_MISC + 512); LAS float* ent_g = (LAS float*)(lds + LDS_MISC + 512 + 4 * NENT); LAS int* ent_s = (LAS int*)(lds + LDS_MISC + 512 + 8 * NENT);
            const float* fg = ffn_norm + (size_t)l * DM;
            { const u32x4* wsrc = (const u32x4*)(ws + WS_WRT + (size_t)l * 131072);
              for (int i = tid; i < 8192; i += 512) *(LAS u32x4*)(lds + i * 16) = wsrc[i]; }
            if (tid < 32) lcnt[tid] = 0;
            for (int i = tid; i < NENT; i += 512) ent_e[i] = -1;
            __syncthreads();
            const int t16 = lane & 15, q = lane >> 4;
            float bias[8];
#pragma unroll
            for (int j = 0; j < 8; ++j) bias[j] = b_router[l * NEXP + 16 * (j >> 2) + 4 * q + (j & 3)];
            f32x4 g4[4];
#pragma unroll
            for (int j = 0; j < 4; ++j) g4[j] = GU_FP8 ? *(const f32x4*)(fg + 16 * lane + 4 * j) : *(const f32x4*)(fg + 4 * lane + 256 * j);
            int itn = 0;
            for (int grp = gw; grp < NTOK / 16; grp += NGW, ++itn) {
                const int row0 = grp * 16;
                const bf16* xp = R16 + (size_t)(row0 + t16) * DM + 8 * q;
                LAS const unsigned char* wl = lds + lane * 16;
                f32x4 a00 = (f32x4){0.f, 0.f, 0.f, 0.f}, a01 = a00, a10 = a00, a11 = a00, ss = a00;
#pragma unroll
                for (int s = 0; s < 32; ++s) {
                    const bf16x8 xf = *(const bf16x8*)(xp + 32 * s);
                    const bf16x8 w00 = *(const LAS bf16x8*)(wl + (s * 4 + 0) * 1024), w01 = *(const LAS bf16x8*)(wl + (s * 4 + 1) * 1024);
                    const bf16x8 w10 = *(const LAS bf16x8*)(wl + (s * 4 + 2) * 1024), w11 = *(const LAS bf16x8*)(wl + (s * 4 + 3) * 1024);
                    a00 = MFMA16(w00, xf, a00); a01 = MFMA16(w01, xf, a01); a10 = MFMA16(w10, xf, a10); a11 = MFMA16(w11, xf, a11);
                    ss = MFMA16(xf, xf, ss);
                }
                const int sel = t16 & 3;
                const float mine = (sel == 0) ? ss[0] : (sel == 1) ? ss[1] : (sel == 2) ? ss[2] : ss[3];
                const float ssq = __builtin_bit_cast(float, __builtin_amdgcn_ds_bpermute((t16 + 16 * (t16 >> 2)) << 2, __builtin_bit_cast(int, mine)));
                const float rs = rsqrtf(ssq * (1.f / DM) + RMS_EPS);
                float lg[8]; int key[8];
#pragma unroll
                for (int j = 0; j < 8; ++j) { const float d = (j < 4) ? (a00[j & 3] + a01[j & 3]) : (a10[j & 3] + a11[j & 3]); lg[j] = d * rs + bias[j];
                    const int e = 16 * (j >> 2) + 4 * q + (j & 3); const int bb = __builtin_bit_cast(int, lg[j]); const int kk = (bb >= 0) ? bb : (bb ^ 0x7fffffff); key[j] = (kk & ~31) | (31 - e); }
                int es[4]; float vs[4];
#pragma unroll
                for (int k = 0; k < 4; ++k) {
                    int mx = key[0];
#pragma unroll
                    for (int j = 1; j < 8; ++j) mx = key[j] > mx ? key[j] : mx;
                    { const int tt = shxi(mx, lane, 16); mx = tt > mx ? tt : mx; }
                    { const int tt = shxi(mx, lane, 32); mx = tt > mx ? tt : mx; }
                    float vl = -INFINITY;
#pragma unroll
                    for (int j = 0; j < 8; ++j) { const bool hit = (key[j] == mx); vl = hit ? lg[j] : vl; key[j] = hit ? (int)0x80000000 : key[j]; }
                    vl = fmaxf(vl, shx(vl, lane, 16)); vl = fmaxf(vl, shx(vl, lane, 32));
                    es[k] = 31 - (mx & 31); vs[k] = vl;
                }
                const float e1 = __expf(vs[1] - vs[0]), e2 = __expf(vs[2] - vs[0]), e3 = __expf(vs[3] - vs[0]); const float rden = 1.f / (1.f + e1 + e2 + e3);
                { const int e = (q == 0) ? es[0] : (q == 1) ? es[1] : (q == 2) ? es[2] : es[3];
                  const float gt = ((q == 0) ? 1.f : (q == 1) ? e1 : (q == 2) ? e2 : e3) * rden;
                  const int pl = atomicAdd((int*)(lcnt + e), 1);
                  const int ei = (itn * NWAVES + wave) * 64 + t16 * 4 + q;
                  if (ei < NENT) { ent_e[ei] = e | (pl << 8); ent_g[ei] = gt; ent_s[ei] = (row0 + t16) * 4 + q; } }
                if (GU_FP8) {
#pragma unroll
                    for (int r0 = 0; r0 < 16; r0 += 4) {
                        u32x4 y[4][2];
#pragma unroll
                        for (int t = 0; t < 4; ++t)
#pragma unroll
                            for (int j = 0; j < 2; ++j) y[t][j] = *(const u32x4*)(R16 + (size_t)(row0 + r0 + t) * DM + 16 * lane + 8 * j);
#pragma unroll
                        for (int t = 0; t < 4; ++t) { const float rsr = __builtin_bit_cast(float, __builtin_amdgcn_readlane(__builtin_bit_cast(int, rs), r0 + t)); const size_t row = (size_t)(row0 + r0 + t);
                            unsigned o4[4];
#pragma unroll
                            for (int j = 0; j < 4; ++j) { const unsigned lo = (j & 1) ? y[t][j >> 1].z : y[t][j >> 1].x, hi = (j & 1) ? y[t][j >> 1].w : y[t][j >> 1].y;
                                const f32x4 v = (f32x4){bf_lo(lo), bf_hi(lo), bf_lo(hi), bf_hi(hi)}; const f32x4 a = v * rsr * g4[j];
                                o4[j] = pk4_fp8_scaled(a[0], a[1], a[2], a[3], 1.f / H_SCALE); }
                            *(u32x4*)(H8 + row * DM + 16 * lane) = (u32x4){o4[0], o4[1], o4[2], o4[3]}; }
                    }
                } else {
#pragma unroll
                for (int r0 = 0; r0 < 16; r0 += 4) {
                    u32x2 y[4][4];
#pragma unroll
                    for (int t = 0; t < 4; ++t)
#pragma unroll
                        for (int j = 0; j < 4; ++j) y[t][j] = *(const u32x2*)(R16 + (size_t)(row0 + r0 + t) * DM + 4 * lane + 256 * j);
#pragma unroll
                    for (int t = 0; t < 4; ++t) { const float rsr = __builtin_bit_cast(float, __builtin_amdgcn_readlane(__builtin_bit_cast(int, rs), r0 + t)); const size_t row = (size_t)(row0 + r0 + t);
#pragma unroll
                        for (int j = 0; j < 4; ++j) { const f32x4 v = (f32x4){bf_lo(y[t][j].x), bf_hi(y[t][j].x), bf_lo(y[t][j].y), bf_hi(y[t][j].y)}; const f32x4 a = v * rsr * g4[j];
                            if (GU_FP8) *(unsigned*)(H8 + row * DM + 4 * lane + 256 * j) = pk4_fp8_scaled(a[0], a[1], a[2], a[3], 1.f / H_SCALE);
                            else *(u32x2*)(Hb + row * DM + 4 * lane + 256 * j) = (u32x2){cvtpk(a[0], a[1]), cvtpk(a[2], a[3])}; } }
                }
                }
            }
            __syncthreads();
            if (tid < 32) lbase[tid] = (int)atomicAdd(ctl + CW_CNT + l * NEXP + tid, (unsigned)lcnt[tid]);
            __syncthreads();
            for (int i = tid; i < NENT; i += 512) { const int ee = ent_e[i]; if (ee >= 0) { const int e = ee & 255, pl = ee >> 8; const size_t idx = (size_t)e * NTOK + lbase[e] + pl; tok_of[idx] = ent_s[i]; gate_of[idx] = ent_g[i]; } }
        }
        SEAM(pb + 6);
#define MOE_TABLES() LAS int* pst = (LAS int*)(lds + LDS_MISC); LAS int* cn = (LAS int*)(lds + LDS_MISC + 256); \
            __syncthreads(); \
            if (tid < 64) { const int e_ = tid & 31; const int c_ = (int)__hip_atomic_load(ctl + CW_CNT + l * NEXP + e_, __ATOMIC_RELAXED, __HIP_MEMORY_SCOPE_AGENT); const int r_ = c_ & 255; \
                const int a_ = (c_ >> 8) + (r_ > 128 ? 1 : 0), b_ = (r_ >= 1 && r_ <= 128) ? 1 : 0; int sa_ = a_, sb_ = b_;        \
                _Pragma("unroll") for (int o_ = 1; o_ < 32; o_ <<= 1) { const int ta_ = __builtin_amdgcn_ds_bpermute(((tid - o_) & 63) << 2, sa_), tb_ = __builtin_amdgcn_ds_bpermute(((tid - o_) & 63) << 2, sb_); if (e_ >= o_) { sa_ += ta_; sb_ += tb_; } } \
                if (tid < 32) { cn[e_] = c_; pst[e_] = sa_ - a_; pst[128 + e_] = sb_ - b_; if (e_ == 31) { pst[NEXP] = sa_; pst[128 + NEXP] = sb_; } } } \
            __syncthreads(); \
            const int P = pst[NEXP] + pst[128 + NEXP]
        if (IN(pb + 7)) for (int rep_ = 0; rep_ < NREP(7); ++rep_) {
            PH_BEGIN;
            MOE_TABLES();
            pg8::MoeSched<0> S; S.pitchB = GU_FP8 ? 1024 : 2048; S.colB = 0; S.pst = pst; S.cn = cn; S.slots = lds + GEMM_SLOT0; S.NT = 8; S.G = G; S.c = bx; S.P = P; S.nunits = P * 8;
            S.tok = tok_of; S.gate = gate_of; S.bias = b_gu + (size_t)l * NEXP * 2048;
            pg8::EpiSwiglu E{ACT, 8, GU_FP8 ? 1.f / (H_SCALE * W_SCALE) : 1.f, DN_FP8 ? ACT_SCALE : 1.f};
            if (GU_FP8) pg8::gemm_phase<pg8::EpiSwiglu, pg8::MoeSched<0>, true>(tid, lds, H8, WguT + (size_t)l * NEXP * 2048 * 1024, 1024, S, E);
            else pg8::gemm_phase<pg8::EpiSwiglu, pg8::MoeSched<0>, false>(tid, lds, Hb, (bf16*)WguT + (size_t)l * NEXP * 2048 * 1024, 2048, S, E);
        }
        SEAM(pb + 7);
        if (IN(pb + 8)) for (int rep_ = 0; rep_ < NREP(8); ++rep_) {
            PH_BEGIN;
            MOE_TABLES();
            pg8::MoeSched<1> S; S.pitchB = DN_FP8 ? 1024 : 2048; S.colB = 0; S.pst = pst; S.cn = cn; S.slots = lds + GEMM_SLOT0; S.NT = 4; S.G = G; S.c = bx; S.P = P; S.nunits = P * 4;
            S.tok = tok_of; S.gate = gate_of; S.bias = b_dn + (size_t)l * NEXP * 1024;
            pg8::EpiDown E{YS, 4, DN_FP8 ? 1.f / (ACT_SCALE * W_SCALE) : 1.f};
            if (DN_FP8) pg8::gemm_phase<pg8::EpiDown, pg8::MoeSched<1>, true>(tid, lds, ACT, WdnT + (size_t)l * NEXP * 1024 * 1024, 1024, S, E);
            else pg8::gemm_phase<pg8::EpiDown, pg8::MoeSched<1>, false>(tid, lds, ACT, (bf16*)WdnT + (size_t)l * NEXP * 1024 * 1024, 2048, S, E);
        }
#undef MOE_TABLES
        SEAM(pb + 8);
        if (IN(pb + 9)) for (int rep_ = 0; rep_ < NREP(9); ++rep_) {
            PH_BEGIN;
            const bool lastl = (l == DEPTH - 1);
            const float* g = lastl ? final_norm : attn_norm + (size_t)(l + 1) * DM;
            for (int row0 = gw; row0 < NTOK; row0 += 2 * NGW) {
                f32x4 v[2][4]; u32x4 xin[2][2]; u32x2 y8[2][4][2];
#pragma unroll
                for (int t = 0; t < 2; ++t) { const int row = (row0 + t * NGW < NTOK) ? row0 + t * NGW : row0; const bf16* x16 = R16 + (size_t)row * DM;
#pragma unroll
                    for (int j = 0; j < 2; ++j) xin[t][j] = *(const u32x4*)(x16 + 8 * lane + 512 * j);
#pragma unroll
                    for (int k = 0; k < 4; ++k) { const unsigned char* yr8 = (const unsigned char*)YS + ((size_t)row * 4 + k) * DM;
#pragma unroll
                        for (int j = 0; j < 2; ++j) y8[t][k][j] = *(const u32x2*)(yr8 + 8 * lane + 512 * j); } }
#pragma unroll
                for (int t = 0; t < 2; ++t) { const int row = row0 + t * NGW; bf16* x16 = R16 + (size_t)row * DM; float* xr = Rres + (size_t)row * DM;
#pragma unroll
                    for (int j = 0; j < 2; ++j) { const u32x4 y = xin[t][j];
                        v[t][2 * j] = (f32x4){bf_lo(y.x), bf_hi(y.x), bf_lo(y.y), bf_hi(y.y)}; v[t][2 * j + 1] = (f32x4){bf_lo(y.z), bf_hi(y.z), bf_lo(y.w), bf_hi(y.w)}; }
#pragma unroll
                    for (int k = 0; k < 4; ++k)
#pragma unroll
                        for (int j = 0; j < 2; ++j) { const u32x2 y = y8[t][k][j];
                            const f32x2 a = __builtin_amdgcn_cvt_pk_f32_fp8((int)y.x, false), b = __builtin_amdgcn_cvt_pk_f32_fp8((int)y.x, true), c = __builtin_amdgcn_cvt_pk_f32_fp8((int)y.y, false), d = __builtin_amdgcn_cvt_pk_f32_fp8((int)y.y, true);
                            v[t][2 * j] += (f32x4){a.x, a.y, b.x, b.y} * (1.f / YS_SCALE); v[t][2 * j + 1] += (f32x4){c.x, c.y, d.x, d.y} * (1.f / YS_SCALE); }
                    const float rs = rsqrtf(wave_sum(sumsq4(v[t]), lane) * (1.f / DM) + RMS_EPS);
                    if (row < NTOK) {
                        if (lastl) {
#pragma unroll
                            for (int j = 0; j < 2; ++j) { const f32x4 g0 = *(const f32x4*)(g + 8 * lane + 512 * j), g1 = *(const f32x4*)(g + 8 * lane + 512 * j + 4);
                                *(f32x4*)(xr + 8 * lane + 512 * j) = v[t][2 * j] * rs * g0; *(f32x4*)(xr + 8 * lane + 512 * j + 4) = v[t][2 * j + 1] * rs * g1; }
                        } else {
#pragma unroll
                            for (int j = 0; j < 2; ++j) st16_wt(x16 + 8 * lane + 512 * j, (u32x4){cvtpk(v[t][2 * j][0], v[t][2 * j][1]), cvtpk(v[t][2 * j][2], v[t][2 * j][3]), cvtpk(v[t][2 * j + 1][0], v[t][2 * j + 1][1]), cvtpk(v[t][2 * j + 1][2], v[t][2 * j + 1][3])});
                            if (DG_FP8) norm_store_fp8(v[t], rs, g, H8 + (size_t)row * DM, lane, H_SCALE); else if (NORM_FOLD) { if (lane == 0) ((float*)(ws + WS_RSIN))[row] = rs; } else norm_store_bf16(v[t], rs, g, Hb + (size_t)row * DM, lane);
                        }
                    }
                }
            }
        }
        SEAM(pb + 9);
    }
#undef IN
#undef SEAM

template <int KMASK, int L0, int L1>
__global__ void __launch_bounds__(NWAVES * 64, 2) mk_fwd(Args args) {
    extern __shared__ __attribute__((aligned(16))) unsigned char lds_raw[];
    LAS unsigned char* lds = (LAS unsigned char*)lds_raw;
    asm volatile("s_setreg_imm32_b32 hwreg(HW_REG_MODE, 23, 1), 1");
    const int wave0 = __builtin_amdgcn_readfirstlane((int)threadIdx.x >> 6);
    if (wave0 == 0) ((LAS unsigned*)(lds + LDS_CTL))[lane_id()] = 0u;
    __syncthreads();
    constexpr bool MULTI = (KMASK & (KMASK - 1)) != 0;
    XcdBarrier bar; { CArgsP ap_ = (CArgsP)(unsigned long long)__builtin_amdgcn_kernarg_segment_ptr(); unsigned char* const ws = ap_->ws; bar.bar = ctl + CW_BAR; bar.x = 0; bar.st = nullptr; bar.w = wave0;
        if (MULTI) bar = xcd_barrier_post(ctl + CW_BAR, (volatile LAS unsigned*)(lds + LDS_CTL), wave0); }
#define IN(k) (((KMASK >> (k)) & 1) != 0)
#define SEAM(k) do { if (MULTI) xcd_barrier(bar); } while (0)

    if (IN(10)) for (int rep_ = 0; rep_ < NREP(10); ++rep_) {
        PH_BEGIN;
        LAS float* scr = (LAS float*)(lds + wave * 17408);
        constexpr int I_GU = (GU_FP8 ? 8 : 16) * 64, I_DN = (DN_FP8 ? 8 : 16) * 32, I_IN = 16 * 61, I_O = 16 * 32, I_UQ = 4 * 24, I_UKV = 2 * 32;
        constexpr int S_GU = DEPTH * NEXP * I_GU, S_DN = DEPTH * NEXP * I_DN, S_IN = DEPTH * I_IN, S_O = DEPTH * I_O, S_UQ = DEPTH * I_UQ, S_UKV = DEPTH * I_UKV;
        constexpr int NITEMS = S_GU + S_DN + S_IN + S_O + S_UQ + S_UKV;
        for (int it = (BG_CONV ? S_GU + S_DN : 0) + gw; it < NITEMS; it += NGW) {
            int r = it;
            if (r < S_GU) { const int mi = r / I_GU; if (GU_FP8) cvt_item_fp8_k128(w_gu + (size_t)mi * 1024 * 2048, 1024, 2048, WguT + (size_t)mi * 2048 * 1024, scr, r % I_GU, lane, MapWgu{}, W_SCALE); else cvt_item(w_gu + (size_t)mi * 1024 * 2048, 1024, 2048, (bf16*)WguT + (size_t)mi * 2048 * 1024, scr, r % I_GU, lane, MapWgu{}); continue; } r -= S_GU;
            if (r < S_DN) { const int mi = r / I_DN; if (DN_FP8) cvt_item_fp8_k128(w_dn + (size_t)mi * 1024 * 1024, 1024, 1024, WdnT + (size_t)mi * 1024 * 1024, scr, r % I_DN, lane, MapIdent{}, W_SCALE); else cvt_item(w_dn + (size_t)mi * 1024 * 1024, 1024, 1024, (bf16*)WdnT + (size_t)mi * 1024 * 1024, scr, r % I_DN, lane, MapIdent{}); continue; } r -= S_DN;
            if (r < S_IN) { const int l = r / I_IN; if (DG_FP8) cvt_item_fp8(w_in + (size_t)l * 1024 * D_IN, 1024, D_IN, (unsigned char*)WinT + (size_t)l * NPROJ * 1024, scr, r % I_IN, lane, MapWin{}, W_SCALE); else if (NORM_FOLD) cvt_item(w_in + (size_t)l * 1024 * D_IN, 1024, D_IN, WinT + (size_t)l * NPROJ * 1024, scr, r % I_IN, lane, MapWinG{attn_norm + (size_t)l * DM}); else cvt_item(w_in + (size_t)l * 1024 * D_IN, 1024, D_IN, WinT + (size_t)l * NPROJ * 1024, scr, r % I_IN, lane, MapWin{}); continue; } r -= S_IN;
            if (r < S_O) { const int l = r / I_O; if (DG_FP8) cvt_item_fp8(w_o + (size_t)l * 1024 * 1024, 1024, 1024, (unsigned char*)WoT + (size_t)l * 1024 * 1024, scr, r % I_O, lane, MapIdent{}, W_SCALE); else if (MIX_FUSED) cvt_item(w_o + (size_t)l * 1024 * 1024, 1024, 1024, WoT + (size_t)l * 1024 * 1024, scr, r % I_O, lane, MapKG{mix_norm + l * 1024}); else cvt_item(w_o + (size_t)l * 1024 * 1024, 1024, 1024, WoT + (size_t)l * 1024 * 1024, scr, r % I_O, lane, MapIdent{}); continue; } r -= S_O;
            if (r < S_UQ) { const int l = r / I_UQ; cvt_item(w_uq + (size_t)l * 256 * 768, 256, 768, WuqT + (size_t)l * 768 * 256, scr, r % I_UQ, lane, MapWuq{q_norm + l * 256}); continue; } r -= S_UQ;
            { const int l = r / I_UKV; cvt_item(w_ukv + (size_t)l * 128 * 1024, 128, 1024, WukvT + (size_t)l * 1024 * 128, scr, r % I_UKV, lane, MapKG{kv_norm + l * 128}); }
        }
        for (int i = bx * 512 + tid; i < DEPTH * 96 * 128; i += G * 512) { const int l = i / (96 * 128), rr = i % (96 * 128);
            if (DG_FP8) { if (rr < 96 * 64) *(u32x4*)((unsigned char*)WinT + (size_t)l * NPROJ * 1024 + (size_t)416 * 1024 + (size_t)rr * 16) = (u32x4){0u, 0u, 0u, 0u}; }
            else *(u32x4*)(WinT + (size_t)l * NPROJ * 1024 + (size_t)416 * 1024 + (size_t)rr * 8) = (u32x4){0u, 0u, 0u, 0u}; }
        for (int i = bx * 512 + tid; i < DEPTH * 32 * 2 * 64; i += G * 512) { const int ln = i & 63, blk = (i >> 6) & 1, s = (i >> 7) & 31, l = i >> 12;
            const int e = 16 * blk + (ln & 15), k0 = 32 * s + 8 * (ln >> 4);
            const float* wp = w_router + ((size_t)l * DM + k0) * NEXP + e; const float* gp = ffn_norm + (size_t)l * DM + k0;
            unsigned hi[4], lo[4];
#pragma unroll
            for (int j = 0; j < 4; ++j) { const float a = wp[(2 * j) * NEXP] * gp[2 * j], b = wp[(2 * j + 1) * NEXP] * gp[2 * j + 1];
                hi[j] = cvtpk(a, b); lo[j] = cvtpk(a - bf_lo(hi[j]), b - bf_hi(hi[j])); }
            u32x4* dst = (u32x4*)(ws + WS_WRT) + (size_t)(((l * 32 + s) * 2 + blk) * 2) * 64 + ln;
            dst[0] = (u32x4){hi[0], hi[1], hi[2], hi[3]}; dst[64] = (u32x4){lo[0], lo[1], lo[2], lo[3]}; }
        for (int i = bx * 512 + tid; i < NTOK * 16; i += G * 512) { const int row = i >> 4, fi = i & 15;
            const float inv = exp2f(-(float)fi * 0.8304820237218406f); const float ang = (float)positions[row] * inv;
            const double rev = (double)ang * 0.15915494309189535; const float fr = (float)(rev - rint(rev));
            ropecs[i] = (f32x2){__builtin_amdgcn_cosf(fr), __builtin_amdgcn_sinf(fr)}; }
        for (int row0 = gw; row0 < NTOK; row0 += 4 * NGW) {
            f32x4 v[4][4];
#pragma unroll
            for (int t = 0; t < 4; ++t) { const int row = row0 + t * NGW; const float* xr = x_in + (size_t)(row < NTOK ? row : row0) * DM;
#pragma unroll
                for (int j = 0; j < 2; ++j) { v[t][2 * j] = __builtin_nontemporal_load((const f32x4*)(xr + 8 * lane + 512 * j)); v[t][2 * j + 1] = __builtin_nontemporal_load((const f32x4*)(xr + 8 * lane + 512 * j + 4)); } }
#pragma unroll
            for (int t = 0; t < 4; ++t) { const int row = row0 + t * NGW;
                const float rs = rsqrtf(wave_sum(sumsq4(v[t]), lane) * (1.f / DM) + RMS_EPS);
                if (row < NTOK) { if (DG_FP8) norm_store_fp8(v[t], rs, attn_norm, H8 + (size_t)row * DM, lane, H_SCALE);
                    else if (NORM_FOLD) { bf16* x16 = R16 + (size_t)row * DM;
#pragma unroll
                        for (int j = 0; j < 2; ++j) st16_wt(x16 + 8 * lane + 512 * j, (u32x4){cvtpk(v[t][2 * j][0], v[t][2 * j][1]), cvtpk(v[t][2 * j][2], v[t][2 * j][3]), cvtpk(v[t][2 * j + 1][0], v[t][2 * j + 1][1]), cvtpk(v[t][2 * j + 1][2], v[t][2 * j + 1][3])});
                        if (lane == 0) ((float*)(ws + WS_RSIN))[row] = rs; }
                    else norm_store_bf16(v[t], rs, attn_norm, Hb + (size_t)row * DM, lane); } }
        }
    }
    SEAM(10);

    if constexpr (L0 < L1) layer_body<KMASK, L0>(lds, bar);
    if constexpr (L0 + 1 < L1) layer_body<KMASK, L0 + 1>(lds, bar);
    static_assert(L1 - L0 <= 2, "two layers");
#undef IN
#undef SEAM
}

extern "C" void kernel_launch(void* const* d_in, const int* in_sizes, int n_in, void* d_out, int out_size, void* d_ws, size_t ws_size, hipStream_t stream) {
    static int grid = 0;
    if (grid == 0) {
        if (n_in != 19 || out_size != NTOK * DM || ws_size < WS_END) { fprintf(stderr, "kernel_launch: unexpected shapes (n_in %d, out %d, ws %zu < %zu)\n", n_in, out_size, ws_size, (size_t)WS_END); grid = -1; return; }
        int dev = 0, cus = 0, per_cu = 0;
        if (hipGetDevice(&dev) != hipSuccess || hipDeviceGetAttribute(&cus, hipDeviceAttributeMultiprocessorCount, dev) != hipSuccess) { grid = -1; return; }
#if MK_PER_PHASE
#define SETATTR1(MASK, L) ok = ok && (hipFuncSetAttribute((const void*)mk_fwd<MASK, L, L + 1>, hipFuncAttributeMaxDynamicSharedMemorySize, LDS_BYTES) == hipSuccess)
#define SETATTR(MASK) SETATTR1(MASK, 0); SETATTR1(MASK, 1)
        bool ok = (hipFuncSetAttribute((const void*)mk_fwd<0x400, 0, 0>, hipFuncAttributeMaxDynamicSharedMemorySize, LDS_BYTES) == hipSuccess);
        SETATTR(0x001); SETATTR(0x002); SETATTR(0x004); SETATTR(0x008); SETATTR(0x010); SETATTR(0x020); SETATTR(0x040); SETATTR(0x080); SETATTR(0x100); SETATTR(0x200);
        if (!ok) { fprintf(stderr, "kernel_launch: hipFuncSetAttribute failed\n"); grid = -1; return; }
        per_cu = 1;
#else
        if (hipFuncSetAttribute((const void*)mk_fwd<0x7FF, 0, DEPTH>, hipFuncAttributeMaxDynamicSharedMemorySize, LDS_BYTES) != hipSuccess) { fprintf(stderr, "kernel_launch: hipFuncSetAttribute failed\n"); grid = -1; return; }
        if (hipOccupancyMaxActiveBlocksPerMultiprocessor(&per_cu, (const void*)mk_fwd<0x7FF, 0, DEPTH>, NWAVES * 64, LDS_BYTES) != hipSuccess || per_cu < 1)
            fprintf(stderr, "kernel_launch: occupancy query reports %d workgroups per CU\n", per_cu);
#endif
        (void)hipGetLastError();
        grid = cus;
    }
    if (grid < 0) return;
    if (hipMemsetAsync((char*)d_ws + WS_CTL, 0, CTL_ZERO_BYTES, stream) != hipSuccess) return;
    Args a{};
    for (int i = 0; i < 19; ++i) a.in[i] = (const float*)d_in[i];
    a.out = (float*)d_out; a.ws = (unsigned char*)d_ws;
#if MK_PER_PHASE
#define LAUNCH1(MASK, L) hipLaunchKernelGGL((mk_fwd<MASK, L, L + 1>), dim3(grid), dim3(NWAVES * 64), LDS_BYTES, stream, a)
#define LAUNCHL(L) do { LAUNCH1(0x001, L); LAUNCH1(0x002, L); LAUNCH1(0x004, L); LAUNCH1(0x008, L); LAUNCH1(0x010, L); LAUNCH1(0x020, L); LAUNCH1(0x040, L); LAUNCH1(0x080, L); LAUNCH1(0x100, L); LAUNCH1(0x200, L); } while (0)
    hipLaunchKernelGGL((mk_fwd<0x400, 0, 0>), dim3(grid), dim3(NWAVES * 64), LDS_BYTES, stream, a);
    LAUNCHL(0); LAUNCHL(1);
#else
    hipLaunchKernelGGL((mk_fwd<0x7FF, 0, DEPTH>), dim3(grid), dim3(NWAVES * 64), LDS_BYTES, stream, a);
#endif
    const hipError_t le = hipPeekAtLastError();
    if (le != hipSuccess) fprintf(stderr, "kernel_launch: launch failed: %s\n", hipGetErrorName(le));
}
```
